# Optimizing an MI355X kernel written in HIP

```python
import jax, jax.numpy as jnp
from jax import lax
import numpy as np

D_MODEL = 1024
BATCH = 4
SEQ = 8192
DEPTH = 2

D_MIX = D_MODEL
CONV_DIM = D_MIX // 4
CONV_K = 3
MLA_HEADS = 8
MLA_NOPE = 64
MLA_ROPE = 32
MLA_V = 64
MLA_Q_RANK = 384
MLA_KV_RANK = 256
LRU_DIM = D_MIX // 4
LRU_BLOCKS = 4
LRU_BW = LRU_DIM // LRU_BLOCKS
LRU_CONV_K = 4
LRU_C = 8.0
ROPE_THETA = 10000.0
Q_BLOCK = 128
D_FF = 3584
N_EXPERTS = 8
TOP_K = 2
N_DENSE = (DEPTH + 1) // 2
N_MOE = DEPTH // 2
DN_ALPHA = (2.0 * DEPTH) ** 0.25
DN_BETA = (8.0 * DEPTH) ** -0.25
LN_EPS = 1e-5
RMS_EPS = 1e-6

IN_SPLITS = (CONV_DIM, CONV_DIM, CONV_DIM, MLA_Q_RANK, MLA_KV_RANK, MLA_ROPE, LRU_DIM, LRU_DIM)
D_IN = sum(IN_SPLITS)
MIX_SPLITS = (CONV_DIM, MLA_HEADS * MLA_V, LRU_DIM)

kernel_name = "hymba_style_conv_mla_rglru_moe_encoder"


def _offsets(sizes):
    return np.cumsum(sizes)[:-1].tolist()


def layer_norm(x, g, b):
    xf = x.astype(jnp.float32)
    mu = jnp.mean(xf, axis=-1, keepdims=True)
    xc = xf - mu
    var = jnp.mean(xc * xc, axis=-1, keepdims=True)
    return (xc * lax.rsqrt(var + LN_EPS) * g + b).astype(x.dtype)


def rms_norm(x, g):
    xf = x.astype(jnp.float32)
    ms = jnp.mean(xf * xf, axis=-1, keepdims=True)
    return (xf * lax.rsqrt(ms + RMS_EPS) * g).astype(x.dtype)


def depthwise_conv(x, w, pad):
    c = x.shape[-1]
    return lax.conv_general_dilated(
        x, w[:, None, :].astype(x.dtype), window_strides=(1,), padding=[pad],
        dimension_numbers=("NWC", "WIO", "NWC"), feature_group_count=c)


def rope_tables(seq):
    pos = jnp.arange(seq, dtype=jnp.float32)
    inv = ROPE_THETA ** (-jnp.arange(0, MLA_ROPE, 2, dtype=jnp.float32) / MLA_ROPE)
    ang = pos[:, None] * inv[None, :]
    return jnp.cos(ang), jnp.sin(ang)


def apply_rope(x, cos, sin):
    xf = x.astype(jnp.float32)
    x1, x2 = jnp.split(xf, 2, axis=-1)
    return jnp.concatenate([x1 * cos - x2 * sin, x2 * cos + x1 * sin], axis=-1).astype(x.dtype)


def short_conv_mixer(b_gate, c_gate, h, w_conv):
    return b_gate * depthwise_conv(c_gate * h, w_conv, (1, 1))


def mla_mixer(c_q, c_kv, k_r, q_norm_g, w_uq, kv_norm_g, w_ukv, cos, sin):
    b, s, _ = c_q.shape
    q = jnp.einsum('bsr,re->bse', rms_norm(c_q, q_norm_g), w_uq).reshape(b, s, MLA_HEADS, MLA_NOPE + MLA_ROPE)
    kv = jnp.einsum('bsr,re->bse', rms_norm(c_kv, kv_norm_g), w_ukv).reshape(b, s, MLA_HEADS, MLA_NOPE + MLA_V)
    scale = (MLA_NOPE + MLA_ROPE) ** -0.5
    q_nope = q[..., :MLA_NOPE] * scale
    q_rope = apply_rope(q[..., MLA_NOPE:], cos[:, None, :], sin[:, None, :]) * scale
    k_nope, v = kv[..., :MLA_NOPE], kv[..., MLA_NOPE:]
    k_rope = apply_rope(k_r, cos, sin)
    nb = s // Q_BLOCK
    qn = q_nope.reshape(b, nb, Q_BLOCK, MLA_HEADS, MLA_NOPE).transpose(1, 0, 2, 3, 4)
    qr = q_rope.reshape(b, nb, Q_BLOCK, MLA_HEADS, MLA_ROPE).transpose(1, 0, 2, 3, 4)

    def attend(blk):
        qn_b, qr_b = blk
        sc = (jnp.einsum('bqhd,bkhd->bhqk', qn_b, k_nope, preferred_element_type=jnp.float32)
              + jnp.einsum('bqhr,bkr->bhqk', qr_b, k_rope, preferred_element_type=jnp.float32))
        p = jax.nn.softmax(sc, axis=-1).astype(v.dtype)
        return jnp.einsum('bhqk,bkhd->bqhd', p, v)

    o = lax.map(attend, (qn, qr))
    return o.transpose(1, 0, 2, 3, 4).reshape(b, s, MLA_HEADS * MLA_V)


def rglru_scan(x, w_a, b_a, w_i, b_i, lam, reverse):
    b, s, _ = x.shape
    xb = x.reshape(b, s, LRU_BLOCKS, LRU_BW)
    ga = jnp.einsum('bsnc,ncd->bsnd', xb, w_a).reshape(b, s, LRU_DIM) + b_a
    gi = jnp.einsum('bsnc,ncd->bsnd', xb, w_i).reshape(b, s, LRU_DIM) + b_i
    rec = jax.nn.sigmoid(ga.astype(jnp.float32))
    inp = jax.nn.sigmoid(gi.astype(jnp.float32))
    log_a = -LRU_C * rec * jax.nn.softplus(-lam.astype(jnp.float32))
    a = jnp.exp(log_a)
    u = jnp.sqrt(-jnp.expm1(2.0 * log_a)) * (inp * x.astype(jnp.float32))

    def combine(left, right):
        a1, b1 = left
        a2, b2 = right
        return a1 * a2, a2 * b1 + b2

    _, h = lax.associative_scan(combine, (a, u), axis=1, reverse=reverse)
    return h


def griffin_recurrent(g_in, x_in, conv_w, conv_b, w_a, b_a, w_i, b_i, lam):
    xc = depthwise_conv(x_in, conv_w, (1, 2)) + conv_b
    h = (rglru_scan(xc, w_a[0], b_a[0], w_i[0], b_i[0], lam[0], False)
         + rglru_scan(xc, w_a[1], b_a[1], w_i[1], b_i[1], lam[1], True))
    return (jax.nn.gelu(g_in.astype(jnp.float32), approximate=True) * h).astype(g_in.dtype)


def hybrid_mixer(x, w_in, conv_w, q_norm_g, w_uq, kv_norm_g, w_ukv, lru_conv_w, lru_conv_b,
                 lru_wa, lru_ba, lru_wi, lru_bi, lru_lam, mix_norm_g, w_out, cos, sin):
    z = jnp.einsum('bsd,de->bse', x, w_in)
    cb, cc, ch, c_q, c_kv, k_r, lg, lx = jnp.split(z, _offsets(IN_SPLITS), axis=-1)
    y_conv = short_conv_mixer(cb, cc, ch, conv_w)
    y_mla = mla_mixer(c_q, c_kv, k_r, q_norm_g, w_uq, kv_norm_g, w_ukv, cos, sin)
    y_lru = griffin_recurrent(lg, lx, lru_conv_w, lru_conv_b, lru_wa, lru_ba, lru_wi, lru_bi, lru_lam)
    g_conv, g_mla, g_lru = jnp.split(mix_norm_g, _offsets(MIX_SPLITS))
    y = jnp.concatenate([rms_norm(y_conv, g_conv), rms_norm(y_mla, g_mla), rms_norm(y_lru, g_lru)], axis=-1)
    return jnp.einsum('bse,ed->bsd', y, w_out)


def swiglu(x, w_gate, w_up, w_down):
    h = jax.nn.silu(x @ w_gate) * (x @ w_up)
    return h @ w_down


def moe_swiglu(x, w_router, w_gate, w_up, w_down):
    b, s, d = x.shape
    xt = x.reshape(b * s, d)
    logits = (xt @ w_router).astype(jnp.float32)
    top_v, top_i = lax.top_k(logits, TOP_K)
    gates = jax.nn.softmax(top_v, axis=-1)
    combine = jnp.einsum('nk,nke->ne', gates, jax.nn.one_hot(top_i, N_EXPERTS, dtype=jnp.float32))
    out = jnp.zeros((b * s, d), jnp.float32)
    for e in range(N_EXPERTS):
        out = out + combine[:, e:e + 1] * swiglu(xt, w_gate[e], w_up[e], w_down[e]).astype(jnp.float32)
    return out.astype(x.dtype).reshape(b, s, d)


def setup_inputs(seed: int = 0) -> dict:
    key = jax.random.key(seed)
    ks = iter(jax.random.split(key, 32))

    def nrm(shape, scale):
        return scale * jax.random.normal(next(ks), shape, jnp.float32)

    def gain(shape):
        return 1.0 + nrm(shape, 0.02)

    x = nrm((BATCH, SEQ, D_MODEL), 1.0)
    ln_in_g = gain((D_MODEL,))
    ln_in_b = nrm((D_MODEL,), 0.02)
    w_in = nrm((DEPTH, D_MODEL, D_IN), D_MODEL ** -0.5)
    conv_w = nrm((DEPTH, CONV_K, CONV_DIM), CONV_K ** -0.5)
    q_norm_g = gain((DEPTH, MLA_Q_RANK))
    w_uq = nrm((DEPTH, MLA_Q_RANK, MLA_HEADS * (MLA_NOPE + MLA_ROPE)), MLA_Q_RANK ** -0.5)
    kv_norm_g = gain((DEPTH, MLA_KV_RANK))
    w_ukv = nrm((DEPTH, MLA_KV_RANK, MLA_HEADS * (MLA_NOPE + MLA_V)), MLA_KV_RANK ** -0.5)
    lru_conv_w = nrm((DEPTH, LRU_CONV_K, LRU_DIM), LRU_CONV_K ** -0.5)
    lru_conv_b = nrm((DEPTH, LRU_DIM), 0.02)
    lru_wa = nrm((DEPTH, 2, LRU_BLOCKS, LRU_BW, LRU_BW), LRU_BW ** -0.5)
    lru_ba = nrm((DEPTH, 2, LRU_DIM), 0.02)
    lru_wi = nrm((DEPTH, 2, LRU_BLOCKS, LRU_BW, LRU_BW), LRU_BW ** -0.5)
    lru_bi = nrm((DEPTH, 2, LRU_DIM), 0.02)
    u = jax.random.uniform(next(ks), (DEPTH, 2, LRU_DIM), jnp.float32, minval=0.9, maxval=0.999)
    a0 = u ** (1.0 / LRU_C)
    lru_lam = jnp.log(a0) - jnp.log1p(-a0)
    mix_norm_g = gain((DEPTH, D_MIX))
    w_out = nrm((DEPTH, D_MIX, D_MODEL), DN_BETA * D_MIX ** -0.5)
    ln1_g = gain((DEPTH, D_MODEL))
    ln1_b = nrm((DEPTH, D_MODEL), 0.02)
    dense_w_gate = nrm((N_DENSE, D_MODEL, D_FF), D_MODEL ** -0.5)
    dense_w_up = nrm((N_DENSE, D_MODEL, D_FF), D_MODEL ** -0.5)
    dense_w_down = nrm((N_DENSE, D_FF, D_MODEL), DN_BETA * D_FF ** -0.5)
    moe_w_router = nrm((N_MOE, D_MODEL, N_EXPERTS), D_MODEL ** -0.5)
    moe_w_gate = nrm((N_MOE, N_EXPERTS, D_MODEL, D_FF), D_MODEL ** -0.5)
    moe_w_up = nrm((N_MOE, N_EXPERTS, D_MODEL, D_FF), D_MODEL ** -0.5)
    moe_w_down = nrm((N_MOE, N_EXPERTS, D_FF, D_MODEL), DN_BETA * D_FF ** -0.5)
    ln2_g = gain((DEPTH, D_MODEL))
    ln2_b = nrm((DEPTH, D_MODEL), 0.02)
    return {"x": x, "ln_in_g": ln_in_g, "ln_in_b": ln_in_b, "w_in": w_in, "conv_w": conv_w,
            "q_norm_g": q_norm_g, "w_uq": w_uq, "kv_norm_g": kv_norm_g, "w_ukv": w_ukv,
            "lru_conv_w": lru_conv_w, "lru_conv_b": lru_conv_b, "lru_wa": lru_wa, "lru_ba": lru_ba,
            "lru_wi": lru_wi, "lru_bi": lru_bi, "lru_lam": lru_lam, "mix_norm_g": mix_norm_g,
            "w_out": w_out, "ln1_g": ln1_g, "ln1_b": ln1_b, "dense_w_gate": dense_w_gate,
            "dense_w_up": dense_w_up, "dense_w_down": dense_w_down, "moe_w_router": moe_w_router,
            "moe_w_gate": moe_w_gate, "moe_w_up": moe_w_up, "moe_w_down": moe_w_down,
            "ln2_g": ln2_g, "ln2_b": ln2_b}


def reference(x, ln_in_g, ln_in_b, w_in, conv_w, q_norm_g, w_uq, kv_norm_g, w_ukv,
              lru_conv_w, lru_conv_b, lru_wa, lru_ba, lru_wi, lru_bi, lru_lam, mix_norm_g,
              w_out, ln1_g, ln1_b, dense_w_gate, dense_w_up, dense_w_down, moe_w_router,
              moe_w_gate, moe_w_up, moe_w_down, ln2_g, ln2_b):
    cos, sin = rope_tables(x.shape[1])
    x = layer_norm(x, ln_in_g, ln_in_b)
    for l in range(DEPTH):
        mix = hybrid_mixer(x, w_in[l], conv_w[l], q_norm_g[l], w_uq[l], kv_norm_g[l], w_ukv[l],
                           lru_conv_w[l], lru_conv_b[l], lru_wa[l], lru_ba[l], lru_wi[l], lru_bi[l],
                           lru_lam[l], mix_norm_g[l], w_out[l], cos, sin)
        x = layer_norm(DN_ALPHA * x + mix, ln1_g[l], ln1_b[l])
        if l % 2 == 0:
            j = l // 2
            f = swiglu(x, dense_w_gate[j], dense_w_up[j], dense_w_down[j])
        else:
            j = l // 2
            f = moe_swiglu(x, moe_w_router[j], moe_w_gate[j], moe_w_up[j], moe_w_down[j])
        x = layer_norm(DN_ALPHA * x + f, ln2_g[l], ln2_b[l])
    return x
```

```cpp
#include <hip/hip_runtime.h>
#include <cstdio>
#include <cstdint>
#include <cmath>

#define LAS __attribute__((address_space(3)))
#define GAS __attribute__((address_space(1)))
typedef unsigned short bf16_t;
typedef short bf16x8 __attribute__((ext_vector_type(8)));
typedef float f32x4 __attribute__((ext_vector_type(4)));
typedef float f32x2 __attribute__((ext_vector_type(2)));
typedef float f32x16 __attribute__((ext_vector_type(16)));
typedef unsigned u32x4 __attribute__((ext_vector_type(4)));
typedef unsigned u32x2 __attribute__((ext_vector_type(2)));

#ifndef MEGA
#define MEGA 1
#endif

constexpr int NTOK = 32768, SEQ = 8192, NBATCH = 4, DM = 1024, DIN = 1952, DINP = 2048, DFF = 3584, NEXP = 8;
constexpr int ZC_B = 0, ZC_C = 256, ZC_H = 512, ZC_Q = 768, ZC_KV = 1152, ZC_KR = 1408, ZC_LG = 1440, ZC_LX = 1696;
constexpr int QW = 768, QRANK = 384, KVRANK = 256;
constexpr float DN_ALPHA = 1.41421356237309515f;
constexpr float LN_EPS = 1e-5f, RMS_EPS = 1e-6f;
constexpr float QSCALE = 0.10206207261596575f * 1.4426950408889634f;
constexpr int LRU_CH = 128, LRU_NCH = SEQ / LRU_CH;

constexpr size_t MiB = 1u << 20;
constexpr size_t WS_CTL = 0, CTL_ZERO_BYTES = 65536;
constexpr size_t WS_ROPE = 1 * MiB;
constexpr size_t WS_RSQ = 2 * MiB, WS_RSKV = 2 * MiB + 131072;
constexpr size_t WS_AGGA = 3 * MiB, WS_AGGH = 3 * MiB + 524288;
constexpr size_t WS_TOKE = 4 * MiB, WS_TOKR = 4 * MiB + 262144, WS_TOKG = 4 * MiB + 524288;
constexpr size_t WS_LIST = 5 * MiB, WS_GLIST = 7 * MiB;
constexpr size_t WS_LRUW = 9 * MiB, WS_C8SP = 9 * MiB + 262144;
constexpr size_t WS_WIN = 10 * MiB, WS_WUQ = 18 * MiB, WS_WK = 20 * MiB, WS_WV = 20 * MiB + 524288, WS_WOUT = 21 * MiB, WS_WGU = 25 * MiB, WS_WD = 39 * MiB;
constexpr size_t WS_XB = 46 * MiB;
constexpr size_t WS_R = 110 * MiB;
constexpr size_t WS_Z = WS_R, WS_Q = WS_R + 128 * MiB, WS_KN = WS_R + 176 * MiB, WS_KR = WS_R + 208 * MiB, WS_VT = WS_R + 210 * MiB, WS_Y = WS_R + 242 * MiB;
constexpr size_t WS_CQN = WS_R + 306 * MiB, WS_CKVN = WS_R + 330 * MiB;
constexpr size_t WS_H = WS_R;
constexpr size_t WS_WGUM = WS_R, WS_WDM = WS_R + 112 * MiB, WS_HM = WS_R + 168 * MiB;
constexpr size_t WS_END = WS_R + 394 * MiB;
constexpr int CW_TMO = 0, CW_BAR = 4096, CW_CNT = 8192;

constexpr int RING_BYTES = 131072, MISC_OFF = RING_BYTES, LDS_BYTES = 147456;

__device__ __forceinline__ unsigned f2bf(float f) { unsigned u = __builtin_bit_cast(unsigned, f); return (u + 0x7fffu + ((u >> 16) & 1u)) >> 16; }
__device__ __forceinline__ unsigned pk2(float lo, float hi) { unsigned r; asm volatile("v_cvt_pk_bf16_f32 %0, %1, %2" : "=v"(r) : "v"(lo), "v"(hi)); return r; }
__device__ __forceinline__ float bf2f(unsigned short b) { return __builtin_bit_cast(float, (unsigned)b << 16); }
__device__ __forceinline__ float bflo(unsigned w) { return __builtin_bit_cast(float, w << 16); }
__device__ __forceinline__ float bfhi(unsigned w) { return __builtin_bit_cast(float, w & 0xffff0000u); }
__device__ __forceinline__ float wave_sum(float v) {
#pragma unroll
    for (int o = 1; o < 64; o <<= 1) v += __shfl_xor(v, o);
    return v;
}
__device__ __forceinline__ float sigmoidf_(float x) { return 1.0f / (1.0f + __expf(-x)); }
__device__ __forceinline__ float gelu_tanh(float x) { const float u = 0.7978845608028654f * (x + 0.044715f * x * x * x); return 0.5f * x * (1.0f + tanhf(u)); }
#define LDS_WAIT() asm volatile("s_waitcnt lgkmcnt(0)" ::: "memory")
#define VM_WAIT() asm volatile("s_waitcnt vmcnt(0)" ::: "memory")

namespace pg8 {
constexpr int BM = 256, BK = 64, HALF = 128, HTB = HALF * BK * 2, STAGE_BYTES = 8 * HTB, NXCD = 8, WGM = 8;
__host__ __device__ __forceinline__ int lds_byte(int r, int c) { const int st = (r >> 4) * 2 + (c >> 5), rr = r & 15, cc = c & 31, ob = rr * 64 + cc * 2; return st * 1024 + (ob ^ (((ob >> 9) & 1) << 5)); }
__host__ __device__ __forceinline__ void stage_rc(int b, int& R, int& C) { const int st = b / 1024, sb = b % 1024, swz = sb ^ (((sb >> 9) & 1) << 5); R = (st >> 1) * 16 + swz / 64; C = (st & 1) * 32 + (swz % 64) / 2; }
__host__ __device__ __forceinline__ int perm32(int rho) { const int n = rho >> 4, i = rho & 15; return 8 * (i >> 2) + 4 * n + (i & 3); }

struct Unit { int pm, pn, e, valid, rowbase, lbase; };
struct Gemm { const bf16_t* A; const bf16_t* Bt; int lda, ldb, K; };

struct StaticOrder {
    int nM, nN, nwg, G, c; size_t astep, bstep;
    __device__ void init(int M, int N, int G_, int c_, int lda, int ldb) { nM = M / BM; nN = N / BM; nwg = nM * nN; G = G_; c = c_; astep = (size_t)BM * lda * 2; bstep = (size_t)BM * ldb * 2; }
    __device__ bool next(int i, Unit& u) const {
        const long L = (long)i * G + c; if (L >= nwg) return false;
        int wgid = (int)L; { const int q = nwg / NXCD, r = nwg % NXCD, xcd = wgid % NXCD, off = wgid / NXCD; wgid = (xcd < r ? xcd * (q + 1) : r * (q + 1) + (xcd - r) * q) + off; }
        const int nig = WGM * nN, gid = wgid / nig, fm = gid * WGM, gsz = (nM - fm) < WGM ? (nM - fm) : WGM;
        u.pm = fm + ((wgid % nig) % gsz); u.pn = (wgid % nig) / gsz; u.e = 0; u.valid = 256; u.rowbase = u.pm * BM; u.lbase = 0; return true;
    }
    __device__ __forceinline__ size_t a_off(const Unit& u) const { return (size_t)u.pm * astep; }
    __device__ __forceinline__ size_t b_off(const Unit& u) const { return (size_t)u.pn * bstep; }
    __device__ __forceinline__ int row_tok(const Unit&, int) const { return 0; }
};

struct MoeOrder {
    int G, c, nN, pass; const unsigned* counts; const int* list; size_t bexp, bstep, astep;
    __device__ void init(const unsigned* counts_, int pass_, int nN_, int G_, int c_, const int* list_, int, int lda, int ldb, size_t bexp_) {
        G = G_; c = c_; nN = nN_; pass = pass_; list = list_; counts = counts_ + pass_ * 8; bexp = bexp_; bstep = (size_t)BM * ldb * 2; astep = (size_t)lda * 2;
    }
    __device__ bool next(int i, Unit& u) const {
        const int L = i * G + c;
        int e = -1, c0 = 0, np = 1, cn = 0, s0 = 0, a = 0, s = 0;
#pragma unroll
        for (int k = 0; k < 8; ++k) { const int n = __builtin_amdgcn_readfirstlane((int)__hip_atomic_load(counts + k, __ATOMIC_RELAXED, __HIP_MEMORY_SCOPE_AGENT)); const int npk = (n + 255) >> 8;
            if (L >= a * nN && L < (a + npk) * nN) { e = k; c0 = a; np = npk; cn = n; s0 = s; }
            a += npk; s += n; }
        if (e < 0) return false;
        const int le = L - c0 * nN; const int pn = le / np, j = le % np;
        u.e = e; u.pn = pn; u.pm = j; u.valid = (cn - 256 * j) < 256 ? (cn - 256 * j) : 256; u.rowbase = s0 + 256 * j; u.lbase = (pass * 8 + e) * NTOK + 256 * j; return true;
    }
    __device__ __forceinline__ size_t a_off(const Unit& u) const { return (size_t)u.rowbase * astep; }
    __device__ __forceinline__ size_t b_off(const Unit& u) const { return (size_t)u.e * bexp + (size_t)u.pn * bstep; }
    __device__ __forceinline__ int row_tok(const Unit& u, int R) const { return (R < u.valid) ? list[u.lbase + R] : 0; }
};

template <class Epi, class Sched, bool ALIGN_EPI, bool GATHER>
__device__ __forceinline__ void gemm_phase(LAS unsigned char* lds, const Gemm g, const Sched& S, const Epi& E) {
    int tid_ = threadIdx.x; asm volatile("" : "+v"(tid_));
    const int tid = tid_, wid = __builtin_amdgcn_readfirstlane(tid >> 6), lane = tid & 63, wr = wid >> 2, wc = wid & 3, fr = lane & 15, fq = lane >> 4;
    const int K = g.K, nt = K / BK;
    unsigned voffA[2], voffB[2]; int RA0, CA0;
#pragma unroll
    for (int i = 0; i < 2; ++i) { int R, C; stage_rc(tid * 16 + i * 8192, R, C); const int Rb = Epi::PERM ? ((R & ~31) + perm32(R & 31)) : R;
        if (i == 0) { RA0 = R; CA0 = C; } voffA[i] = (unsigned)(R * g.lda + C) * 2u; voffB[i] = (unsigned)(Rb * g.ldb + C) * 2u; }
    LAS int* tokt = (LAS int*)(lds + STAGE_BYTES + 1024);
    const size_t kstep = (size_t)(BK * 2);
    const size_t hstepA = GATHER ? 0 : (size_t)HALF * g.lda * 2, hstepB = (size_t)HALF * g.ldb * 2;
    const unsigned ldsw = (unsigned)wid * 1024u;
    const int aoff = lds_byte(wr * 64 + fr, fq * 8), boff = lds_byte(wc * 32 + fr, fq * 8);
#define PG8_SA(b, h) (((b) * 2 + (h)) * HTB)
#define PG8_SB(b, h) ((4 + (b) * 2 + (h)) * HTB)
#define PG8_STAGE(bufoff, gbase, v0, v1) do { \
        __builtin_amdgcn_global_load_lds((const unsigned*)((const char*)(gbase) + (v0)), (LAS unsigned*)(lds + (bufoff) + ldsw), 16, 0, 0); \
        __builtin_amdgcn_global_load_lds((const unsigned*)((const char*)(gbase) + (v1)), (LAS unsigned*)(lds + (bufoff) + ldsw + 8192), 16, 0, 0); } while (0)
#define PG8_STAGEB(bufoff, gbase) PG8_STAGE(bufoff, gbase, voffB[0], voffB[1])
#define PG8_STAGEA(bufoff, gbase, h, nx) do { if constexpr (GATHER) { const LAS int* tt_ = tokt + (((ui + ((nx) ? 1 : 0)) & 1) << 8) + (h) * HALF + RA0; \
            const unsigned o0_ = (unsigned)tt_[0] * (unsigned)(g.lda * 2) + (unsigned)(CA0 * 2), o1_ = (unsigned)tt_[64] * (unsigned)(g.lda * 2) + (unsigned)(CA0 * 2); PG8_STAGE(bufoff, gbase, o0_, o1_); } \
        else PG8_STAGE(bufoff, (gbase) + (h) * hstepA, voffA[0], voffA[1]); } while (0)
#define PG8_LDA(dst, b, h) do { _Pragma("unroll") for (int m = 0; m < 4; ++m) _Pragma("unroll") for (int k = 0; k < 2; ++k) dst[m][k] = *(const LAS bf16x8*)(lds + PG8_SA(b, h) + aoff + m * 2048 + k * 1024); } while (0)
#define PG8_LDB(dst, b, h) do { _Pragma("unroll") for (int n = 0; n < 2; ++n) _Pragma("unroll") for (int k = 0; k < 2; ++k) dst[n][k] = *(const LAS bf16x8*)(lds + PG8_SB(b, h) + boff + n * 2048 + k * 1024); } while (0)
#define PG8_MMA(ai, bj, At, Bt) do { __builtin_amdgcn_s_setprio(1); _Pragma("unroll") for (int m = 0; m < 4; ++m) _Pragma("unroll") for (int n = 0; n < 2; ++n) _Pragma("unroll") for (int k = 0; k < 2; ++k) \
        acc[ai][bj][m][n] = __builtin_amdgcn_mfma_f32_16x16x32_bf16(Bt[n][k], At[m][k], acc[ai][bj][m][n], 0, 0, 0); __builtin_amdgcn_s_setprio(0); } while (0)
#define PG8_WAIT_V(n) asm volatile("s_waitcnt vmcnt(" #n ")" ::: "memory")
#define PG8_WAIT_L(n) asm volatile("s_waitcnt lgkmcnt(" #n ")" ::: "memory")
#define PG8_BAR __builtin_amdgcn_s_barrier()
#define PG8_SCHED __builtin_amdgcn_sched_barrier(0)
#define PG8_GTOK(u, slot) do { if constexpr (GATHER) { if (tid < 256) tokt[((slot) & 1) * 256 + tid] = S.row_tok(u, tid); } } while (0)
    Unit cur, nxt; int ui = 0;
    if (!S.next(0, cur)) return;
    f32x4 acc[2][2][4][2];
#pragma unroll
    for (int a = 0; a < 2; ++a)
#pragma unroll
        for (int b = 0; b < 2; ++b)
#pragma unroll
            for (int m = 0; m < 4; ++m)
#pragma unroll
                for (int n = 0; n < 2; ++n) acc[a][b][m][n] = (f32x4){0.f, 0.f, 0.f, 0.f};
    bf16x8 At[4][2], B0[2][2], B1[2][2];
    const char* cA = (const char*)g.A + (GATHER ? (size_t)0 : S.a_off(cur)); const char* cB = (const char*)g.Bt + S.b_off(cur);
    if constexpr (GATHER) { PG8_GTOK(cur, 0); asm volatile("s_waitcnt lgkmcnt(0)" ::: "memory"); __builtin_amdgcn_s_barrier(); asm volatile("" ::: "memory"); }
    PG8_STAGEB(PG8_SB(0, 0), cB); PG8_STAGEB(PG8_SB(0, 1), cB + hstepB); PG8_STAGEA(PG8_SA(0, 0), cA, 0, false); PG8_STAGEA(PG8_SA(0, 1), cA, 1, false);
    if (wr == 1) PG8_BAR;
    PG8_WAIT_V(2); PG8_BAR;
    PG8_STAGEB(PG8_SB(1, 0), cB + kstep); PG8_STAGEA(PG8_SA(1, 0), cA + kstep, 0, false); PG8_STAGEB(PG8_SB(1, 1), cB + hstepB + kstep);
    PG8_WAIT_V(6); PG8_BAR;
    for (;;) {
        const bool has_next = S.next(ui + 1, nxt);
        const char* nA = has_next ? (const char*)g.A + (GATHER ? (size_t)0 : S.a_off(nxt)) : cA; const char* nB = has_next ? (const char*)g.Bt + S.b_off(nxt) : cB;
        if constexpr (GATHER) { if (has_next) PG8_GTOK(nxt, ui + 1); else PG8_GTOK(cur, ui + 1); }
#pragma unroll 1
        for (int t = 0; t < nt; t += 2) {
            const bool last = (t == nt - 2);
            const char* a1 = cA + (size_t)(t + 1) * kstep;
            const char* a2 = last ? nA : cA + (size_t)(t + 2) * kstep; const char* b2 = last ? nB : cB + (size_t)(t + 2) * kstep;
            const char* a3 = a2 + kstep; const char* b3 = b2 + kstep;
            PG8_LDB(B0, 0, 0); PG8_LDB(B1, 0, 1); PG8_SCHED; PG8_LDA(At, 0, 0); PG8_STAGEA(PG8_SA(1, 1), a1, 1, false);
            PG8_WAIT_V(8); PG8_WAIT_L(0); PG8_BAR; PG8_MMA(0, 0, At, B0); PG8_MMA(0, 1, At, B1); PG8_BAR; PG8_SCHED;
            PG8_LDA(At, 0, 1); PG8_STAGEB(PG8_SB(0, 0), b2); PG8_STAGEB(PG8_SB(0, 1), b2 + hstepB); PG8_STAGEA(PG8_SA(0, 0), a2, 0, last);
            PG8_WAIT_V(8); PG8_WAIT_L(0); PG8_BAR; PG8_MMA(1, 0, At, B0); PG8_MMA(1, 1, At, B1); PG8_BAR; PG8_SCHED;
            PG8_LDB(B0, 1, 0); PG8_LDB(B1, 1, 1); PG8_SCHED; PG8_LDA(At, 1, 0); PG8_STAGEA(PG8_SA(0, 1), a2, 1, last);
            PG8_WAIT_V(8); PG8_WAIT_L(0); PG8_BAR; PG8_MMA(0, 0, At, B0); PG8_MMA(0, 1, At, B1); PG8_BAR; PG8_SCHED;
            PG8_LDA(At, 1, 1); PG8_STAGEB(PG8_SB(1, 0), b3); PG8_STAGEB(PG8_SB(1, 1), b3 + hstepB); PG8_STAGEA(PG8_SA(1, 0), a3, 0, last);
            PG8_WAIT_V(8); PG8_WAIT_L(0); PG8_BAR; PG8_MMA(1, 0, At, B0); PG8_MMA(1, 1, At, B1); PG8_BAR; PG8_SCHED;
        }
        if constexpr (ALIGN_EPI) { if (wr == 0) PG8_BAR; }
        E(acc, cur, wr, wc, fr, fq);
        if (!has_next) break;
#pragma unroll
        for (int a = 0; a < 2; ++a)
#pragma unroll
            for (int b = 0; b < 2; ++b)
#pragma unroll
                for (int m = 0; m < 4; ++m)
#pragma unroll
                    for (int n = 0; n < 2; ++n) acc[a][b][m][n] = (f32x4){0.f, 0.f, 0.f, 0.f};
        cur = nxt; cA = nA; cB = nB; ++ui;
        if constexpr (ALIGN_EPI) { if (wr == 1) PG8_BAR; }
    }
    PG8_WAIT_V(0);
    if constexpr (!ALIGN_EPI) { if (wr == 0) PG8_BAR; }
    PG8_BAR;
#undef PG8_SA
#undef PG8_SB
#undef PG8_STAGE
#undef PG8_STAGEA
#undef PG8_STAGEB
#undef PG8_LDA
#undef PG8_LDB
#undef PG8_MMA
#undef PG8_WAIT_V
#undef PG8_WAIT_L
#undef PG8_BAR
#undef PG8_SCHED
#undef PG8_GTOK
}
}
using pg8::Unit;

typedef f32x4 Acc[2][2][4][2];
struct EpiStore {
    static constexpr bool PERM = true;
    bf16_t* O; int ldc; const float* rowscale;
    __device__ __forceinline__ void operator()(Acc& acc, const Unit& u, int wr, int wc, int fr, int fq) const {
        const int row0 = u.pm * 256 + wr * 64 + fr, col0 = u.pn * 256 + wc * 32 + 8 * fq;
#pragma unroll
        for (int ai = 0; ai < 2; ++ai)
#pragma unroll
            for (int m = 0; m < 4; ++m) { const int row = row0 + ai * 128 + m * 16; const float s = rowscale ? rowscale[row] : 1.f;
                asm volatile("" : "+v"(acc[ai][0][m][0]), "+v"(acc[ai][0][m][1]), "+v"(acc[ai][1][m][0]), "+v"(acc[ai][1][m][1])); bf16_t* rowp = O + ((unsigned)row * (unsigned)ldc + (unsigned)col0);
#pragma unroll
                for (int bj = 0; bj < 2; ++bj) { const f32x4 v0 = acc[ai][bj][m][0] * s, v1 = acc[ai][bj][m][1] * s;
                    u32x4 w; w.x = pk2(v0[0], v0[1]); w.y = pk2(v0[2], v0[3]); w.z = pk2(v1[0], v1[1]); w.w = pk2(v1[2], v1[3]);
                    *(u32x4*)(rowp + bj * 128) = w; } }
    }
};
struct EpiQ {
    static constexpr bool PERM = false;
    bf16_t* Q; const f32x2* rope;
    __device__ __forceinline__ void operator()(Acc& acc, const Unit& u, int wr, int wc, int fr, int fq) const {
#pragma unroll
        for (int ai = 0; ai < 2; ++ai)
#pragma unroll
            for (int m = 0; m < 4; ++m) { const int row = u.pm * 256 + ai * 128 + wr * 64 + m * 16 + fr; const int pos = row & (SEQ - 1);
                asm volatile("" : "+v"(acc[ai][0][m][0]), "+v"(acc[ai][0][m][1]), "+v"(acc[ai][1][m][0]), "+v"(acc[ai][1][m][1]));
                const f32x4 t0 = *(const f32x4*)(rope + ((unsigned)pos * 16u + 4u * fq)), t1 = *(const f32x4*)(rope + ((unsigned)pos * 16u + 4u * fq + 2u));
                const float cs[4] = {t0[0], t0[2], t1[0], t1[2]}, sn[4] = {t0[1], t0[3], t1[1], t1[3]};
#pragma unroll
                for (int bj = 0; bj < 2; ++bj) { const int cg = u.pn * 256 + bj * 128 + wc * 32; const bool isrope = ((cg >> 5) % 3) == 2;
                    f32x4 v0 = acc[ai][bj][m][0], v1 = acc[ai][bj][m][1];
                    if (isrope) {
#pragma unroll
                        for (int e = 0; e < 4; ++e) { const float x1 = v0[e], x2 = v1[e]; v0[e] = x1 * cs[e] - x2 * sn[e]; v1[e] = x2 * cs[e] + x1 * sn[e]; } }
                    u32x2 w0, w1; w0.x = pk2(v0[0], v0[1]); w0.y = pk2(v0[2], v0[3]); w1.x = pk2(v1[0], v1[1]); w1.y = pk2(v1[2], v1[3]);
                    bf16_t* p = Q + ((unsigned)row * (unsigned)QW + (unsigned)(cg + 4 * fq)); *(u32x2*)p = w0; *(u32x2*)(p + 16) = w1; }
                asm volatile("" ::: "memory"); }
    }
};
struct EpiVT {
    static constexpr bool PERM = true;
    bf16_t* VT;
    __device__ __forceinline__ void operator()(Acc& acc, const Unit& u, int wr, int wc, int fr, int fq) const {
#pragma unroll
        for (int bj = 0; bj < 2; ++bj) { const int tb = u.pn * 256 + bj * 128 + wc * 32 + 8 * fq; const int base16 = tb & ~15, c = (tb >> 3) & 1;
#pragma unroll
            for (int ai = 0; ai < 2; ++ai)
#pragma unroll
                for (int m = 0; m < 4; ++m) { const int f = u.pm * 256 + ai * 128 + wr * 64 + m * 16 + fr; asm volatile("" : "+v"(acc[ai][bj][m][0]), "+v"(acc[ai][bj][m][1])); const f32x4 v0 = acc[ai][bj][m][0], v1 = acc[ai][bj][m][1];
                    u32x2 w0, w1; w0.x = pk2(v0[0], v0[1]); w0.y = pk2(v0[2], v0[3]); w1.x = pk2(v1[0], v1[1]); w1.y = pk2(v1[2], v1[3]);
                    bf16_t* p = VT + ((unsigned)f * (unsigned)NTOK + (unsigned)(base16 + 4 * c)); *(u32x2*)p = w0; *(u32x2*)(p + 8) = w1; asm volatile("" ::: "memory"); } }
    }
};
struct EpiResid {
    static constexpr bool PERM = false;
    float* X;
    __device__ __forceinline__ void operator()(Acc& acc, const Unit& u, int wr, int wc, int fr, int fq) const {
        const int col0 = u.pn * 256 + wc * 32 + 4 * fq;
#pragma unroll
        for (int ai = 0; ai < 2; ++ai)
#pragma unroll
            for (int m = 0; m < 4; ++m) { const int row = u.pm * 256 + ai * 128 + wr * 64 + m * 16 + fr; float* rp = X + ((unsigned)row * (unsigned)DM + (unsigned)col0);
#pragma unroll
                for (int bj = 0; bj < 2; ++bj)
#pragma unroll
                    for (int n = 0; n < 2; ++n) { f32x4* p = (f32x4*)(rp + bj * 128 + n * 16); const f32x4 x = *p; *p = x * DN_ALPHA + acc[ai][bj][m][n]; } }
    }
};
struct EpiSwiglu {
    static constexpr bool PERM = true;
    bf16_t* H;
    __device__ __forceinline__ void operator()(Acc& acc, const Unit& u, int wr, int wc, int fr, int fq) const {
        const int colh = u.pn * 128 + wc * 32 + 8 * fq;
#pragma unroll
        for (int ai = 0; ai < 2; ++ai)
#pragma unroll
            for (int m = 0; m < 4; ++m) { const int rt = ai * 128 + wr * 64 + m * 16 + fr;
                asm volatile("" : "+v"(acc[ai][0][m][0]), "+v"(acc[ai][0][m][1]), "+v"(acc[ai][1][m][0]), "+v"(acc[ai][1][m][1]));
                float hv[8];
#pragma unroll
                for (int n = 0; n < 2; ++n)
#pragma unroll
                    for (int e = 0; e < 4; ++e) { const float g = acc[ai][0][m][n][e], up = acc[ai][1][m][n][e]; hv[4 * n + e] = g * __builtin_amdgcn_rcpf(1.0f + __expf(-g)) * up; }
                u32x4 w; w.x = pk2(hv[0], hv[1]); w.y = pk2(hv[2], hv[3]); w.z = pk2(hv[4], hv[5]); w.w = pk2(hv[6], hv[7]);
                if (rt < u.valid) *(u32x4*)(H + ((unsigned)(u.rowbase + rt) * (unsigned)DFF + (unsigned)colh)) = w; asm volatile("" ::: "memory"); }
    }
};
struct EpiMoeDown {
    static constexpr bool PERM = false;
    float* X; const int* list; const float* glist; int pass;
    __device__ __forceinline__ void operator()(Acc& acc, const Unit& u, int wr, int wc, int fr, int fq) const {
        const int col0 = u.pn * 256 + wc * 32 + 4 * fq; const float al = pass == 0 ? DN_ALPHA : 1.0f;
#pragma unroll
        for (int ai = 0; ai < 2; ++ai)
#pragma unroll
            for (int m = 0; m < 4; ++m) { const int rt = ai * 128 + wr * 64 + m * 16 + fr;
                if (rt < u.valid) { const int tok = list[u.lbase + rt]; const float gt = glist[u.lbase + rt]; float* rp = X + ((unsigned)tok * (unsigned)DM + (unsigned)col0);
#pragma unroll
                    for (int bj = 0; bj < 2; ++bj)
#pragma unroll
                        for (int n = 0; n < 2; ++n) { f32x4* p = (f32x4*)(rp + bj * 128 + n * 16); const f32x4 x = *p; *p = x * al + acc[ai][bj][m][n] * gt; } } }
    }
};

namespace att {
constexpr int KVB = 64, NT = SEQ / KVB, STG = 20480, NSTG = 3;
__device__ __forceinline__ void glds16(const void* gsrc, unsigned lds_dst) { unsigned keep;
    asm volatile("s_mov_b32 %0, m0\n\ts_mov_b32 m0, %2\n\ts_nop 0\n\tglobal_load_lds_dwordx4 %1, off\n\ts_mov_b32 m0, %0" : "=&s"(keep) : "v"(gsrc), "s"(lds_dst) : "memory"); }
__device__ __forceinline__ void attn_unit(int b, int h, int qb, const bf16_t* Q, const bf16_t* Kn, const bf16_t* Kr, const bf16_t* VT, bf16_t* Y, LAS unsigned char* lds) {
    int tid_ = threadIdx.x; asm volatile("" : "+v"(tid_));
    const int tid = tid_, lane = tid & 63, r32 = lane & 31, hi = lane >> 5; const int wid = __builtin_amdgcn_readfirstlane(tid >> 6);
    const size_t rowbase = (size_t)b * SEQ; const int q0 = qb * 256 + wid * 32;
    bf16x8 qf[6];
    { const bf16_t* qp = Q + (rowbase + q0 + r32) * QW + h * 96 + hi * 8;
#pragma unroll
      for (int d0 = 0; d0 < 6; ++d0) qf[d0] = *(const bf16x8*)(qp + d0 * 16); }
    const char* s0 = (const char*)(Kn + (rowbase + lane) * 512 + h * 64 + wid * 8);
    const char* s1; const char* s2; size_t st1;
    if (wid < 4) { s1 = (const char*)(Kr + (rowbase + lane) * 32 + wid * 8); st1 = (size_t)KVB * 32 * 2;
                   s2 = (const char*)(VT + (size_t)(h * 64 + 32 + r32) * NTOK + rowbase + wid * 16 + hi * 8); }
    else { s1 = (const char*)(VT + (size_t)(h * 64 + r32) * NTOK + rowbase + (wid - 4) * 16 + hi * 8); st1 = (size_t)KVB * 2; s2 = s1; }
    const size_t st0 = (size_t)KVB * 512 * 2, st2 = (size_t)KVB * 2;
    const unsigned lds0 = (unsigned)(uintptr_t)lds;
    const unsigned d0off = (unsigned)wid * 1024u, d1off = (wid < 4) ? (unsigned)(8 + wid) * 1024u : (unsigned)(12 + wid - 4) * 1024u, d2off = (unsigned)(16 + wid) * 1024u;
#define ATT_DMA(t, stg) do { const unsigned sb_ = lds0 + (unsigned)(stg) * STG; \
        glds16(s0 + (size_t)(t) * st0, (unsigned)__builtin_amdgcn_readfirstlane(sb_ + d0off)); \
        glds16(s1 + (size_t)(t) * st1, (unsigned)__builtin_amdgcn_readfirstlane(sb_ + d1off)); \
        if (wid < 4) glds16(s2 + (size_t)(t) * st2, (unsigned)__builtin_amdgcn_readfirstlane(sb_ + d2off)); } while (0)
    float m_run = -INFINITY, l_run = 0.f; f32x16 o0, o1;
#pragma unroll
    for (int r = 0; r < 16; ++r) { o0[r] = 0.f; o1[r] = 0.f; }
    ATT_DMA(0, 0); ATT_DMA(1, 1);
    int stg = 0;
    for (int t = 0; t < NT; ++t) {
        if (t + 1 < NT) { if (wid < 4) asm volatile("s_waitcnt vmcnt(3)" ::: "memory"); else asm volatile("s_waitcnt vmcnt(2)" ::: "memory"); }
        else asm volatile("s_waitcnt vmcnt(0)" ::: "memory");
        asm volatile("s_barrier" ::: "memory");
        if (t + 2 < NT) { const int s2g = (stg == 0) ? 2 : stg - 1; ATT_DMA(t + 2, s2g); }
        const LAS unsigned char* Ks = lds + stg * STG;
        f32x16 p0, p1;
#pragma unroll
        for (int r = 0; r < 16; ++r) { p0[r] = 0.f; p1[r] = 0.f; }
#pragma unroll
        for (int d0 = 0; d0 < 6; ++d0) {
            const bf16x8 a0 = *(const LAS bf16x8*)(Ks + (2 * d0 + hi) * 1024 + r32 * 16);
            const bf16x8 a1 = *(const LAS bf16x8*)(Ks + (2 * d0 + hi) * 1024 + 512 + r32 * 16);
            p0 = __builtin_amdgcn_mfma_f32_32x32x16_bf16(a0, qf[d0], p0, 0, 0, 0);
            p1 = __builtin_amdgcn_mfma_f32_32x32x16_bf16(a1, qf[d0], p1, 0, 0, 0);
        }
        float mx = fmaxf(p0[0], p1[0]);
#pragma unroll
        for (int r = 1; r < 16; ++r) mx = fmaxf(mx, fmaxf(p0[r], p1[r]));
        mx = fmaxf(mx, __shfl_xor(mx, 32));
        const float mnew = fmaxf(m_run, mx); const float alpha = __builtin_amdgcn_exp2f(m_run - mnew); m_run = mnew;
        float ls = 0.f;
#pragma unroll
        for (int r = 0; r < 16; ++r) { p0[r] = __builtin_amdgcn_exp2f(p0[r] - mnew); p1[r] = __builtin_amdgcn_exp2f(p1[r] - mnew); ls += p0[r] + p1[r]; }
        l_run = l_run * alpha + ls;
#pragma unroll
        for (int r = 0; r < 16; ++r) { o0[r] *= alpha; o1[r] *= alpha; }
        bf16x8 pb[4];
        { u32x4 w;
          w.x = pk2(p0[0], p0[1]); w.y = pk2(p0[2], p0[3]); w.z = pk2(p0[4], p0[5]); w.w = pk2(p0[6], p0[7]); pb[0] = __builtin_bit_cast(bf16x8, w);
          w.x = pk2(p0[8], p0[9]); w.y = pk2(p0[10], p0[11]); w.z = pk2(p0[12], p0[13]); w.w = pk2(p0[14], p0[15]); pb[1] = __builtin_bit_cast(bf16x8, w);
          w.x = pk2(p1[0], p1[1]); w.y = pk2(p1[2], p1[3]); w.z = pk2(p1[4], p1[5]); w.w = pk2(p1[6], p1[7]); pb[2] = __builtin_bit_cast(bf16x8, w);
          w.x = pk2(p1[8], p1[9]); w.y = pk2(p1[10], p1[11]); w.z = pk2(p1[12], p1[13]); w.w = pk2(p1[14], p1[15]); pb[3] = __builtin_bit_cast(bf16x8, w); }
        const LAS unsigned char* Vs = Ks + 12288 + lane * 16;
#pragma unroll
        for (int ks = 0; ks < 4; ++ks) {
            const bf16x8 v0 = *(const LAS bf16x8*)(Vs + ks * 1024);
            const bf16x8 v1 = *(const LAS bf16x8*)(Vs + (4 + ks) * 1024);
            o0 = __builtin_amdgcn_mfma_f32_32x32x16_bf16(v0, pb[ks], o0, 0, 0, 0);
            o1 = __builtin_amdgcn_mfma_f32_32x32x16_bf16(v1, pb[ks], o1, 0, 0, 0);
        }
        stg = (stg == 2) ? 0 : stg + 1;
    }
#undef ATT_DMA
    const float l = l_run + __shfl_xor(l_run, 32); const float inv = 1.0f / l;
    bf16_t* yp = Y + (rowbase + q0 + r32) * DM + 256 + h * 64 + 4 * hi;
#pragma unroll
    for (int g = 0; g < 4; ++g) {
        u32x2 w0, w1; w0.x = pk2(o0[4 * g] * inv, o0[4 * g + 1] * inv); w0.y = pk2(o0[4 * g + 2] * inv, o0[4 * g + 3] * inv);
        w1.x = pk2(o1[4 * g] * inv, o1[4 * g + 1] * inv); w1.y = pk2(o1[4 * g + 2] * inv, o1[4 * g + 3] * inv);
        *(u32x2*)(yp + 8 * g) = w0; *(u32x2*)(yp + 32 + 8 * g) = w1; }
    asm volatile("s_waitcnt lgkmcnt(0)\n\ts_barrier" ::: "memory");
}
}

namespace lru {
constexpr int HS_BYTES = 65536, WST = 3 * 16 * 36 * 4;
template <int PASS>
__device__ __forceinline__ void lru_unit(int b, int ck, int layer, const bf16_t* Z, const bf16_t* LW, const float* c8sp, const float* convw, const float* convb, const float* ba, const float* bi,
                                         float* aggA, float* aggH, const float* glru, bf16_t* Y, LAS unsigned char* lds) {
    int tid_ = threadIdx.x; asm volatile("" : "+v"(tid_));
    const int tid = tid_, lane = tid & 63, fr = lane & 15, fq = lane >> 4; const int wid = __builtin_amdgcn_readfirstlane(tid >> 6);
    const int n = wid & 3, hf = wid >> 2, chbase = 64 * n, own = chbase + 32 * hf, c = lane & 31;
    LAS float* xs = (LAS float*)(lds + HS_BYTES + wid * WST); LAS float* as_ = xs + 16 * 36; LAS float* us = as_ + 16 * 36;
    LAS bf16_t* hs = (LAS bf16_t*)lds;
    const int tok0 = b * SEQ + ck * LRU_CH;
    float cw[4][16], cb[16];
#pragma unroll
    for (int e = 0; e < 16; ++e) { const int ch = chbase + (e >> 3) * 32 + 8 * fq + (e & 7); cb[e] = convb[layer * 256 + ch];
#pragma unroll
        for (int k = 0; k < 4; ++k) cw[k][e] = convw[(layer * 4 + k) * 256 + ch]; }
#pragma unroll 1
    for (int sweep = 0; sweep < 2; ++sweep) {
        const int d = (PASS == 2) ? 1 - sweep : sweep;
        bf16x8 wf[2][2][2];
#pragma unroll
        for (int g = 0; g < 2; ++g)
#pragma unroll
            for (int nt = 0; nt < 2; ++nt)
#pragma unroll
                for (int ks = 0; ks < 2; ++ks) wf[g][nt][ks] = *(const bf16x8*)(LW + ((size_t)((((layer * 2 + d) * 2 + g) * 4 + n) * 64 + 32 * hf + 16 * nt + fr)) * 64 + ks * 32 + 8 * fq);
        float bav[2][4], biv[2][4], spv[2][4];
#pragma unroll
        for (int nt = 0; nt < 2; ++nt)
#pragma unroll
            for (int e = 0; e < 4; ++e) { const int ch = own + 16 * nt + 4 * fq + e; bav[nt][e] = ba[(layer * 2 + d) * 256 + ch]; biv[nt][e] = bi[(layer * 2 + d) * 256 + ch]; spv[nt][e] = c8sp[(layer * 2 + d) * 256 + ch]; }
        float hst = 0.f, Pa = 1.f;
        if (PASS == 2) {
            const float* pa = aggA + (size_t)((b * 2 + d) * LRU_NCH) * 256 + own + c; const float* ph = aggH + (size_t)((b * 2 + d) * LRU_NCH) * 256 + own + c;
            if (d == 0) { for (int j = 0; j < ck; ++j) hst = pa[(size_t)j * 256] * hst + ph[(size_t)j * 256]; }
            else { for (int j = LRU_NCH - 1; j > ck; --j) hst = pa[(size_t)j * 256] * hst + ph[(size_t)j * 256]; }
        }
#pragma unroll 1
        for (int s = 0; s < 8; ++s) {
            const int sb = (d == 0) ? s : 7 - s; const int t0 = tok0 + sb * 16;
            float xc[16];
#pragma unroll
            for (int e = 0; e < 16; ++e) xc[e] = cb[e];
#pragma unroll
            for (int k = 0; k < 4; ++k) { const int tk = t0 + fr + k - 1; const int pos = tk - b * SEQ;
                if (pos >= 0 && pos < SEQ) { const bf16_t* zp = Z + (size_t)tk * DINP + ZC_LX + chbase + 8 * fq; const u32x4 v0 = *(const u32x4*)zp, v1 = *(const u32x4*)(zp + 32);
                    xc[0] += cw[k][0] * bflo(v0.x); xc[1] += cw[k][1] * bfhi(v0.x); xc[2] += cw[k][2] * bflo(v0.y); xc[3] += cw[k][3] * bfhi(v0.y);
                    xc[4] += cw[k][4] * bflo(v0.z); xc[5] += cw[k][5] * bfhi(v0.z); xc[6] += cw[k][6] * bflo(v0.w); xc[7] += cw[k][7] * bfhi(v0.w);
                    xc[8] += cw[k][8] * bflo(v1.x); xc[9] += cw[k][9] * bfhi(v1.x); xc[10] += cw[k][10] * bflo(v1.y); xc[11] += cw[k][11] * bfhi(v1.y);
                    xc[12] += cw[k][12] * bflo(v1.z); xc[13] += cw[k][13] * bfhi(v1.z); xc[14] += cw[k][14] * bflo(v1.w); xc[15] += cw[k][15] * bfhi(v1.w); } }
            bf16x8 af0, af1;
            { u32x4 w; w.x = pk2(xc[0], xc[1]); w.y = pk2(xc[2], xc[3]); w.z = pk2(xc[4], xc[5]); w.w = pk2(xc[6], xc[7]); af0 = __builtin_bit_cast(bf16x8, w);
              w.x = pk2(xc[8], xc[9]); w.y = pk2(xc[10], xc[11]); w.z = pk2(xc[12], xc[13]); w.w = pk2(xc[14], xc[15]); af1 = __builtin_bit_cast(bf16x8, w); }
            { f32x4 x0, x1;
              if (hf == 0) { x0 = (f32x4){xc[0], xc[1], xc[2], xc[3]}; x1 = (f32x4){xc[4], xc[5], xc[6], xc[7]}; } else { x0 = (f32x4){xc[8], xc[9], xc[10], xc[11]}; x1 = (f32x4){xc[12], xc[13], xc[14], xc[15]}; }
              *(LAS f32x4*)(xs + fr * 36 + 8 * fq) = x0; *(LAS f32x4*)(xs + fr * 36 + 8 * fq + 4) = x1; }
#pragma unroll
            for (int nt = 0; nt < 2; ++nt) {
                f32x4 ga = (f32x4){0.f, 0.f, 0.f, 0.f}, gi = ga;
                ga = __builtin_amdgcn_mfma_f32_16x16x32_bf16(wf[0][nt][0], af0, ga, 0, 0, 0); ga = __builtin_amdgcn_mfma_f32_16x16x32_bf16(wf[0][nt][1], af1, ga, 0, 0, 0);
                gi = __builtin_amdgcn_mfma_f32_16x16x32_bf16(wf[1][nt][0], af0, gi, 0, 0, 0); gi = __builtin_amdgcn_mfma_f32_16x16x32_bf16(wf[1][nt][1], af1, gi, 0, 0, 0);
                f32x4 av, uv;
#pragma unroll
                for (int e = 0; e < 4; ++e) { const float rec = sigmoidf_(ga[e] + bav[nt][e]), inp = sigmoidf_(gi[e] + biv[nt][e]); const float la = -spv[nt][e] * rec;
                    av[e] = __expf(la); uv[e] = sqrtf(-expm1f(2.0f * la)) * inp; }
                *(LAS f32x4*)(as_ + fr * 36 + 16 * nt + 4 * fq) = av; *(LAS f32x4*)(us + fr * 36 + 16 * nt + 4 * fq) = uv;
            }
            LDS_WAIT();
#pragma unroll
            for (int tt = 0; tt < 16; ++tt) { const int ti = (d == 0) ? tt : 15 - tt; const float a = as_[ti * 36 + c], uu = us[ti * 36 + c] * xs[ti * 36 + c];
                hst = a * hst + uu; Pa *= a;
                if (PASS == 2) { const int row = sb * 16 + ti;
                    if (lane < 32) {
                        if (d == 1) hs[row * 256 + own + c] = (bf16_t)f2bf(hst);
                        else { const float hb = bf2f(hs[row * 256 + own + c]); const float lg = bf2f(Z[(size_t)(tok0 + row) * DINP + ZC_LG + own + c]); hs[row * 256 + own + c] = (bf16_t)f2bf(gelu_tanh(lg) * (hst + hb)); } } } }
            LDS_WAIT();
        }
        if (PASS == 1 && lane < 32) { const size_t o = (size_t)((b * 2 + d) * LRU_NCH + ck) * 256 + own + c; aggA[o] = Pa; aggH[o] = hst; }
    }
    if (PASS == 2) {
        __syncthreads();
#pragma unroll 1
        for (int i = 0; i < 16; ++i) { const int row = wid * 16 + i; const u32x2 w = *(const LAS u32x2*)(hs + row * 256 + 4 * lane);
            const float v0 = bflo(w.x), v1 = bfhi(w.x), v2 = bflo(w.y), v3 = bfhi(w.y);
            const float ss = wave_sum(v0 * v0 + v1 * v1 + v2 * v2 + v3 * v3); const float rs = rsqrtf(ss * (1.0f / 256.0f) + RMS_EPS);
            const f32x4 g = *(const f32x4*)(glru + 4 * lane);
            u32x2 o; o.x = pk2(v0 * rs * g[0], v1 * rs * g[1]); o.y = pk2(v2 * rs * g[2], v3 * rs * g[3]);
            *(u32x2*)(Y + (size_t)(tok0 + row) * DM + 768 + 4 * lane) = o; }
        __syncthreads();
    }
}
}

#define XB_TMO      128
#define XB_XCNT(j)  (256  + 64 * (j))
#define XB_XSUB(j)  (1280 + 64 * (j))
#define XB_XGEN(j)  (2304 + 64 * (j))
#define XB_TOP      3328
#define XB_TOPGEN   3392
#define XCD_BAR_WORDS 3456
#define XB_SPIN_CAP (1u << 18)
__device__ __forceinline__ unsigned xb_ld(unsigned* p)              { return __hip_atomic_load(p, __ATOMIC_RELAXED, __HIP_MEMORY_SCOPE_AGENT); }
__device__ __forceinline__ unsigned xb_add(unsigned* p, unsigned v) { return __hip_atomic_fetch_add(p, v, __ATOMIC_RELAXED, __HIP_MEMORY_SCOPE_AGENT); }
__device__ __forceinline__ unsigned xb_xcc_id() { return (unsigned)__builtin_amdgcn_s_getreg((3 << 11) | 20) & 0xFu; }
#define XB_SPIN(cond, bar) do { unsigned _sp = 0; while (cond) { __builtin_amdgcn_s_sleep(1); \
    if ((++_sp & 255u) == 0u) { if (xb_ld(&(bar)[XB_TMO])) break; if (_sp > XB_SPIN_CAP) { atomicAdd(&(bar)[XB_TMO], 1u); break; } } } } while (0)
struct XcdBarrier { unsigned* bar; unsigned x; volatile LAS unsigned* st; };
__device__ __forceinline__ XcdBarrier xcd_barrier_post(unsigned* bar, volatile LAS unsigned* st) {
    XcdBarrier b; b.bar = bar; b.x = xb_xcc_id(); b.st = st;
    if (threadIdx.x == 0) (void)xb_add(&bar[XB_XCNT(b.x)], 1u);
    return b;
}
__device__ __forceinline__ void xcd_barrier_complete(unsigned* bar, unsigned x, unsigned& nloc, unsigned& nx) {
    const unsigned G = gridDim.x * gridDim.y * gridDim.z;
    unsigned sum, cnt, mine, sp = 0u;
    for (;;) {
        sum = 0u; cnt = 0u; mine = 0u;
#pragma unroll
        for (unsigned j = 0; j < 16; ++j) { const unsigned c = xb_ld(&bar[XB_XCNT(j)]); sum += c; cnt += (c > 0u) ? 1u : 0u; mine = (j == x) ? c : mine; }
        if (sum == G) break;
        __builtin_amdgcn_s_sleep(1);
        if ((++sp & 255u) == 0u) { if (xb_ld(&bar[XB_TMO])) break; if (sp > XB_SPIN_CAP) { atomicAdd(&bar[XB_TMO], 1u); break; } }
    }
    nloc = mine > 0u ? mine : 1u; nx = cnt > 0u ? cnt : 1u;
}
__device__ __forceinline__ void xcd_barrier(const XcdBarrier& b) {
    asm volatile("s_waitcnt vmcnt(0)" ::: "memory");
    __syncthreads();
    if (threadIdx.x == 0) {
        unsigned* bar = b.bar;
        __builtin_amdgcn_s_waitcnt(0);
        unsigned nloc = b.st[0], nx = b.st[1];
        if (nloc == 0u) { xcd_barrier_complete(bar, b.x, nloc, nx); b.st[0] = nloc; b.st[1] = nx; }
        const unsigned old = xb_add(&bar[XB_XSUB(b.x)], 1u);
        const unsigned gen = old / nloc;
        if (old + 1u == (gen + 1u) * nloc) {
            __builtin_amdgcn_fence(__ATOMIC_RELEASE, "agent");
            asm volatile("s_waitcnt vmcnt(0)" ::: "memory");
            const unsigned og = xb_add(&bar[XB_TOP], 1u);
            const unsigned tg = og / nx;
            if (og + 1u == (tg + 1u) * nx) xb_add(&bar[XB_TOPGEN], 1u);
            else XB_SPIN(xb_ld(&bar[XB_TOPGEN]) == tg, bar);
            __builtin_amdgcn_fence(__ATOMIC_ACQUIRE, "agent");
            xb_add(&bar[XB_XGEN(b.x)], 1u);
            asm volatile("s_waitcnt vmcnt(0)" ::: "memory");
        } else {
            XB_SPIN(xb_ld(&bar[XB_XGEN(b.x)]) == gen, bar);
            __builtin_amdgcn_fence(__ATOMIC_ACQUIRE, "agent");
            asm volatile("s_waitcnt vmcnt(0)" ::: "memory");
        }
    }
    __syncthreads();
}

struct Args { const float* in[29]; float* out; unsigned char* ws; int ph_lo, ph_hi; };
enum { I_X = 0, I_LNG, I_LNB, I_WIN, I_CONVW, I_QNG, I_WUQ, I_KVNG, I_WUKV, I_LCW, I_LCB, I_LWA, I_LBA, I_LWI, I_LBI, I_LAM, I_MIXG, I_WOUT, I_LN1G, I_LN1B,
       I_DWG, I_DWU, I_DWD, I_RTR, I_MWG, I_MWU, I_MWD, I_LN2G, I_LN2B };
struct Ctx { LAS unsigned char* lds; int tid, lane, wave, G, blk, gw, ngw; };
typedef const __attribute__((address_space(4))) Args* ArgsP;
__device__ __forceinline__ unsigned char* wsp(ArgsP a) { unsigned long long v = (unsigned long long)a->ws; asm volatile("" : "+s"(v)); return (unsigned char*)v; }
__device__ __forceinline__ ArgsP args_ptr() { unsigned long long v = (unsigned long long)__builtin_amdgcn_kernarg_segment_ptr(); asm volatile("" : "+s"(v)); return (ArgsP)v; }

struct RmId { __device__ __forceinline__ int operator()(int n) const { return n; } };
struct RmGU { int up; __device__ __forceinline__ int operator()(int n) const { return 256 * (n >> 7) + 128 * up + (n & 127); } };
struct RmKV { int v; __device__ __forceinline__ int operator()(int n) const { return (n >> 7) * 64 + (n & 63); } };
template <class RM>
__device__ __forceinline__ void transpose_item(const float* W, int N, bf16_t* WT, int ldo, const float* kscale, LAS float* scr, int kb, int nb, int lane, RM rm, float kmul = 1.0f) {
    const int k0 = 64 * kb, n0 = 32 * nb;
#pragma unroll 8
    for (int i = 0; i < 32; ++i) { const int kk = 2 * i + (lane >> 5); scr[kk * 33 + (lane & 31)] = W[(size_t)(k0 + kk) * N + n0 + (lane & 31)]; }
    LDS_WAIT(); asm volatile("" ::: "memory");
    const int c = lane & 7;
    float ks[8];
#pragma unroll
    for (int e = 0; e < 8; ++e) ks[e] = (kscale ? kscale[k0 + 8 * c + e] : 1.0f) * kmul;
#pragma unroll
    for (int j = 0; j < 4; ++j) { const int n = (lane >> 3) + 8 * j; const LAS float* s = scr + (8 * c) * 33 + n;
        u32x4 o; o.x = pk2(s[0 * 33] * ks[0], s[1 * 33] * ks[1]); o.y = pk2(s[2 * 33] * ks[2], s[3 * 33] * ks[3]); o.z = pk2(s[4 * 33] * ks[4], s[5 * 33] * ks[5]); o.w = pk2(s[6 * 33] * ks[6], s[7 * 33] * ks[7]);
        *(u32x4*)(WT + (size_t)rm(n0 + n) * ldo + k0 + 8 * c) = o; }
    LDS_WAIT(); asm volatile("" ::: "memory");
}
template <class RM>
__device__ __forceinline__ void transpose_matrix(const Ctx& C, int& it0, const float* W, int K, int N, bf16_t* WT, int ldo, const float* kscale, RM rm, float kmul = 1.0f) {
    LAS float* scr = (LAS float*)(C.lds + C.wave * 16384);
    const int nkb = K / 64, nnb = N / 32, total = nkb * nnb;
    int first = (C.gw - (it0 % C.ngw) + C.ngw) % C.ngw;
    for (int it = first; it < total; it += C.ngw) transpose_item(W, N, WT, ldo, kscale, scr, it / nnb, it % nnb, C.lane, rm, kmul);
    it0 += total;
}
__device__ __forceinline__ void ln_row(const float* src, const float* g, const float* bta, float* dstf, bf16_t* dstb, int lane, f32x4 (&v)[4]) {
    float s = 0.f;
#pragma unroll
    for (int j = 0; j < 4; ++j) { v[j] = *(const f32x4*)(src + 4 * lane + 256 * j); s += (v[j][0] + v[j][1]) + (v[j][2] + v[j][3]); }
    const float mean = wave_sum(s) * (1.0f / DM); float s2 = 0.f;
#pragma unroll
    for (int j = 0; j < 4; ++j) { v[j] = v[j] - mean; s2 += (v[j][0] * v[j][0] + v[j][1] * v[j][1]) + (v[j][2] * v[j][2] + v[j][3] * v[j][3]); }
    const float rstd = rsqrtf(wave_sum(s2) * (1.0f / DM) + LN_EPS);
#pragma unroll
    for (int j = 0; j < 4; ++j) { const f32x4 gg = *(const f32x4*)(g + 4 * lane + 256 * j), bb = *(const f32x4*)(bta + 4 * lane + 256 * j);
        v[j] = v[j] * rstd * gg + bb; *(f32x4*)(dstf + 4 * lane + 256 * j) = v[j];
        u32x2 w; w.x = pk2(v[j][0], v[j][1]); w.y = pk2(v[j][2], v[j][3]); *(u32x2*)(dstb + 4 * lane + 256 * j) = w; }
}

__device__ __forceinline__ void phase_prologue(const Ctx& C, ArgsP a) {
    unsigned char* ws = wsp(a); int it0 = 0;
    for (int l = 0; l < 2; ++l) {
        transpose_matrix(C, it0, a->in[I_WIN] + (size_t)l * DM * DIN, DM, DIN, (bf16_t*)(ws + WS_WIN) + (size_t)l * DINP * DM, DM, nullptr, RmId{});
        transpose_matrix(C, it0, a->in[I_WUQ] + (size_t)l * QRANK * QW, QRANK, QW, (bf16_t*)(ws + WS_WUQ) + (size_t)l * QW * QRANK, QRANK, a->in[I_QNG] + l * QRANK, RmId{}, QSCALE);
        transpose_matrix(C, it0, a->in[I_WOUT] + (size_t)l * DM * DM, DM, DM, (bf16_t*)(ws + WS_WOUT) + (size_t)l * DM * DM, DM, nullptr, RmId{});
        { LAS float* scr = (LAS float*)(C.lds + C.wave * 16384); const float* W = a->in[I_WUKV] + (size_t)l * KVRANK * 1024; const int total = 4 * 32;
          int first = (C.gw - (it0 % C.ngw) + C.ngw) % C.ngw;
          for (int it = first; it < total; it += C.ngw) { const int kb = it / 32, nb = it % 32; const bool isv = (nb & 3) >= 2;
              transpose_item(W, 1024, (bf16_t*)(ws + (isv ? WS_WV : WS_WK)) + (size_t)l * 512 * KVRANK, KVRANK, a->in[I_KVNG] + l * KVRANK, scr, kb, nb, C.lane, RmKV{0}); }
          it0 += total; }
        for (int d = 0; d < 2; ++d) for (int g = 0; g < 2; ++g) for (int n = 0; n < 4; ++n)
            transpose_matrix(C, it0, a->in[g == 0 ? I_LWA : I_LWI] + (size_t)(((l * 2 + d) * 4 + n) * 4096), 64, 64, (bf16_t*)(ws + WS_LRUW) + (size_t)((((l * 2 + d) * 2 + g) * 4 + n) * 4096), 64, nullptr, RmId{});
    }
    transpose_matrix(C, it0, a->in[I_DWG], DM, DFF, (bf16_t*)(ws + WS_WGU), DM, nullptr, RmGU{0});
    transpose_matrix(C, it0, a->in[I_DWU], DM, DFF, (bf16_t*)(ws + WS_WGU), DM, nullptr, RmGU{1});
    transpose_matrix(C, it0, a->in[I_DWD], DFF, DM, (bf16_t*)(ws + WS_WD), DFF, nullptr, RmId{});
    const int gt = C.blk * 512 + C.tid, ngt = C.G * 512;
    for (int i = gt; i < 2 * 96 * DM / 8; i += ngt) { const int l = i / (96 * DM / 8), r = i % (96 * DM / 8); *(u32x4*)((bf16_t*)(ws + WS_WIN) + (size_t)l * DINP * DM + (size_t)DIN * DM + (size_t)r * 8) = (u32x4){0u, 0u, 0u, 0u}; }
    for (int i = gt; i < 1024; i += ngt) { const float lam = a->in[I_LAM][i]; ((float*)(ws + WS_C8SP))[i] = 8.0f * (fmaxf(-lam, 0.f) + log1pf(expf(-fabsf(lam)))); }
    for (int i = gt; i < SEQ * 16; i += ngt) { const int pos = i >> 4, k = i & 15; const double inv = exp(-9.210340371976184 * (double)k / 16.0); const double ang = (double)pos * inv;
        ((f32x2*)(ws + WS_ROPE))[i] = (f32x2){(float)cos(ang), (float)sin(ang)}; }
    for (int row = C.gw; row < NTOK; row += C.ngw) { f32x4 v[4]; ln_row(a->in[I_X] + (size_t)row * DM, a->in[I_LNG], a->in[I_LNB], a->out + (size_t)row * DM, (bf16_t*)(ws + WS_XB) + (size_t)row * DM, C.lane, v); }
}

__device__ __forceinline__ void phase_tokenlocal(const Ctx& C, ArgsP a, int l) {
    unsigned char* ws = wsp(a); const bf16_t* Z = (const bf16_t*)(ws + WS_Z); bf16_t* Y = (bf16_t*)(ws + WS_Y); bf16_t* KR = (bf16_t*)(ws + WS_KR);
    bf16_t* CQN = (bf16_t*)(ws + WS_CQN); bf16_t* CKVN = (bf16_t*)(ws + WS_CKVN); const f32x2* rope = (const f32x2*)(ws + WS_ROPE);
    const int lane = C.lane;
    const float* cwp = a->in[I_CONVW] + (size_t)l * 3 * 256; const f32x4 w0 = *(const f32x4*)(cwp + 4 * lane), w1 = *(const f32x4*)(cwp + 256 + 4 * lane), w2 = *(const f32x4*)(cwp + 512 + 4 * lane);
    const f32x4 gc = *(const f32x4*)(a->in[I_MIXG] + (size_t)l * DM + 4 * lane);
    for (int row = C.gw; row < NTOK; row += C.ngw) {
        const bf16_t* zr = Z + (size_t)row * DINP; const int pos = row & (SEQ - 1);
        float sq = 0.f; float qx[6];
#pragma unroll
        for (int j = 0; j < 3; ++j) { const unsigned w = *(const unsigned*)(zr + ZC_Q + 2 * lane + 128 * j); qx[2 * j] = bflo(w); qx[2 * j + 1] = bfhi(w); sq += qx[2 * j] * qx[2 * j] + qx[2 * j + 1] * qx[2 * j + 1]; }
        const u32x2 wk = *(const u32x2*)(zr + ZC_KV + 4 * lane); const float k0 = bflo(wk.x), k1 = bfhi(wk.x), k2 = bflo(wk.y), k3 = bfhi(wk.y);
        const float skv = wave_sum(k0 * k0 + k1 * k1 + k2 * k2 + k3 * k3); sq = wave_sum(sq);
        { const float rq = rsqrtf(sq * (1.0f / QRANK) + RMS_EPS), rk = rsqrtf(skv * (1.0f / KVRANK) + RMS_EPS);
#pragma unroll
          for (int j = 0; j < 3; ++j) *(unsigned*)(CQN + (size_t)row * QRANK + 2 * lane + 128 * j) = pk2(qx[2 * j] * rq, qx[2 * j + 1] * rq);
          u32x2 o; o.x = pk2(k0 * rk, k1 * rk); o.y = pk2(k2 * rk, k3 * rk); *(u32x2*)(CKVN + (size_t)row * KVRANK + 4 * lane) = o; }
        if (lane < 16) { const float x1 = bf2f(zr[ZC_KR + lane]), x2 = bf2f(zr[ZC_KR + 16 + lane]); const f32x2 cs = rope[(size_t)pos * 16 + lane];
            KR[(size_t)row * 32 + lane] = (bf16_t)f2bf(x1 * cs[0] - x2 * cs[1]); KR[(size_t)row * 32 + 16 + lane] = (bf16_t)f2bf(x2 * cs[0] + x1 * cs[1]); }
        f32x4 acc = (f32x4){0.f, 0.f, 0.f, 0.f};
#pragma unroll
        for (int k = 0; k < 3; ++k) { const int p2 = pos + k - 1;
            if (p2 >= 0 && p2 < SEQ) { const bf16_t* zz = zr + (ptrdiff_t)(k - 1) * DINP; const u32x2 cw_ = *(const u32x2*)(zz + ZC_C + 4 * lane), hw = *(const u32x2*)(zz + ZC_H + 4 * lane);
                const f32x4 ch = (f32x4){bflo(cw_.x) * bflo(hw.x), bfhi(cw_.x) * bfhi(hw.x), bflo(cw_.y) * bflo(hw.y), bfhi(cw_.y) * bfhi(hw.y)};
                acc += (k == 0 ? w0 : (k == 1 ? w1 : w2)) * ch; } }
        const u32x2 bw = *(const u32x2*)(zr + ZC_B + 4 * lane);
        acc = acc * (f32x4){bflo(bw.x), bfhi(bw.x), bflo(bw.y), bfhi(bw.y)};
        const float ss = wave_sum(acc[0] * acc[0] + acc[1] * acc[1] + acc[2] * acc[2] + acc[3] * acc[3]); const float rs = rsqrtf(ss * (1.0f / 256.0f) + RMS_EPS);
        u32x2 o; o.x = pk2(acc[0] * rs * gc[0], acc[1] * rs * gc[1]); o.y = pk2(acc[2] * rs * gc[2], acc[3] * rs * gc[3]);
        *(u32x2*)(Y + (size_t)row * DM + 4 * lane) = o;
    }
    for (int u = C.blk; u < NBATCH * LRU_NCH; u += C.G)
        lru::lru_unit<1>(u / LRU_NCH, u % LRU_NCH, l, Z, (const bf16_t*)(ws + WS_LRUW), (const float*)(ws + WS_C8SP), a->in[I_LCW], a->in[I_LCB], a->in[I_LBA], a->in[I_LBI],
                         (float*)(ws + WS_AGGA), (float*)(ws + WS_AGGH), a->in[I_MIXG] + (size_t)l * DM + 768, Y, C.lds);
}

__device__ __forceinline__ void phase_mlanorm(const Ctx& C, ArgsP a, int l) {
    bf16_t* Y = (bf16_t*)(a->ws + WS_Y); const int lane = C.lane; const float* g = a->in[I_MIXG] + (size_t)l * DM + 256 + 8 * lane;
    const f32x4 g0 = *(const f32x4*)g, g1 = *(const f32x4*)(g + 4);
    for (int row = C.gw; row < NTOK; row += C.ngw) { u32x4* p = (u32x4*)(Y + (size_t)row * DM + 256 + 8 * lane); const u32x4 w = *p;
        float v[8] = {bflo(w.x), bfhi(w.x), bflo(w.y), bfhi(w.y), bflo(w.z), bfhi(w.z), bflo(w.w), bfhi(w.w)}; float s = 0.f;
#pragma unroll
        for (int e = 0; e < 8; ++e) s += v[e] * v[e];
        const float rs = rsqrtf(wave_sum(s) * (1.0f / 512.0f) + RMS_EPS);
        u32x4 o; o.x = pk2(v[0] * rs * g0[0], v[1] * rs * g0[1]); o.y = pk2(v[2] * rs * g0[2], v[3] * rs * g0[3]); o.z = pk2(v[4] * rs * g1[0], v[5] * rs * g1[1]); o.w = pk2(v[6] * rs * g1[2], v[7] * rs * g1[3]);
        *p = o; }
}

template <bool ROUTE>
__device__ __forceinline__ void phase_ln(const Ctx& C, ArgsP a, const float* g, const float* bta) {
    unsigned char* ws = wsp(a); float* X = a->out; bf16_t* XB = (bf16_t*)(ws + WS_XB);
    LAS float* wr_ = (LAS float*)C.lds;
    LAS unsigned* hist = (LAS unsigned*)(C.lds + 32768);
    unsigned* cnt = (unsigned*)(ws + WS_CTL) + CW_CNT;
    int* tok_e = (int*)(ws + WS_TOKE); int* tok_r = (int*)(ws + WS_TOKR); float* tok_g = (float*)(ws + WS_TOKG);
    if (ROUTE) {
        for (int i = C.tid; i < DM * NEXP / 4; i += 512) ((LAS f32x4*)wr_)[i] = ((const f32x4*)a->in[I_RTR])[i];
        if (C.tid < 32) hist[C.tid] = 0u;
        __syncthreads();
    }
    for (int row = C.gw; row < NTOK; row += C.ngw) {
        f32x4 v[4]; ln_row(X + (size_t)row * DM, g, bta, X + (size_t)row * DM, XB + (size_t)row * DM, C.lane, v);
        if (ROUTE) {
            float lg[8];
#pragma unroll
            for (int e = 0; e < 8; ++e) lg[e] = 0.f;
#pragma unroll
            for (int j = 0; j < 4; ++j)
#pragma unroll
                for (int q = 0; q < 4; ++q) { const int c = 4 * C.lane + 256 * j + q; const f32x4 wa = *(const LAS f32x4*)(wr_ + c * 8), wb = *(const LAS f32x4*)(wr_ + c * 8 + 4); const float x = v[j][q];
                    lg[0] += x * wa[0]; lg[1] += x * wa[1]; lg[2] += x * wa[2]; lg[3] += x * wa[3]; lg[4] += x * wb[0]; lg[5] += x * wb[1]; lg[6] += x * wb[2]; lg[7] += x * wb[3]; }
#pragma unroll
            for (int e = 0; e < 8; ++e) lg[e] = wave_sum(lg[e]);
            int e0 = 0; float v0 = lg[0];
#pragma unroll
            for (int e = 1; e < 8; ++e) if (lg[e] > v0) { v0 = lg[e]; e0 = e; }
            int e1 = -1; float v1 = -INFINITY;
#pragma unroll
            for (int e = 0; e < 8; ++e) if (e != e0 && lg[e] > v1) { v1 = lg[e]; e1 = e; }
            const float g0 = 1.0f / (1.0f + expf(v1 - v0)), g1 = 1.0f - g0;
            if (C.lane == 0) { const unsigned r0 = atomicAdd((unsigned*)&hist[e0], 1u), r1 = atomicAdd((unsigned*)&hist[8 + e1], 1u);
                tok_e[row] = e0; tok_e[NTOK + row] = e1; tok_r[row] = (int)r0; tok_r[NTOK + row] = (int)r1; tok_g[row] = g0; tok_g[NTOK + row] = g1; }
        }
    }
    if (ROUTE) {
        VM_WAIT(); __syncthreads();
        if (C.tid < 16) hist[16 + C.tid] = atomicAdd(&cnt[C.tid], hist[C.tid]);
        __syncthreads();
        int* list = (int*)(ws + WS_LIST); float* glist = (float*)(ws + WS_GLIST);
        for (int row = C.gw; row < NTOK; row += C.ngw) {
            if (C.lane < 2) { const int p = C.lane; const int e = tok_e[p * NTOK + row]; const int slot = (int)hist[16 + p * 8 + e] + tok_r[p * NTOK + row];
                list[(size_t)(p * 8 + e) * NTOK + slot] = row; glist[(size_t)(p * 8 + e) * NTOK + slot] = tok_g[p * NTOK + row]; } }
        __syncthreads();
        int it0 = 0;
        for (int e = 0; e < NEXP; ++e) {
            transpose_matrix(C, it0, a->in[I_MWG] + (size_t)e * DM * DFF, DM, DFF, (bf16_t*)(ws + WS_WGUM) + (size_t)e * 2 * DFF * DM, DM, nullptr, RmGU{0});
            transpose_matrix(C, it0, a->in[I_MWU] + (size_t)e * DM * DFF, DM, DFF, (bf16_t*)(ws + WS_WGUM) + (size_t)e * 2 * DFF * DM, DM, nullptr, RmGU{1});
            transpose_matrix(C, it0, a->in[I_MWD] + (size_t)e * DFF * DM, DFF, DM, (bf16_t*)(ws + WS_WDM) + (size_t)e * DM * DFF, DFF, nullptr, RmId{});
        }
    }
}

constexpr int NPH_LAYER = 12, NPHASES = 1 + 2 * NPH_LAYER;
template <int KSEL>
__global__ void __launch_bounds__(512, 2) fwd_kernel(Args a_) {
    extern __shared__ __attribute__((aligned(16))) unsigned char lds_raw[];
    Ctx C0; C0.lds = (LAS unsigned char*)lds_raw; C0.tid = threadIdx.x; C0.lane = C0.tid & 63; C0.wave = __builtin_amdgcn_readfirstlane(C0.tid >> 6);
    C0.G = gridDim.x; C0.blk = blockIdx.x; C0.gw = C0.blk * 8 + C0.wave; C0.ngw = C0.G * 8;
    unsigned char* ws0 = a_.ws;
    volatile LAS unsigned* MISC = (volatile LAS unsigned*)(C0.lds + MISC_OFF);
    if (C0.tid < 64) MISC[C0.tid] = 0u;
    __syncthreads();
    XcdBarrier bar; bar.bar = (unsigned*)(ws0 + WS_CTL) + CW_BAR; bar.x = 0; bar.st = MISC + 8;
    const int lo = a_.ph_lo, hi = a_.ph_hi;
    const bool multi = (KSEL < 0) && (hi - lo) > 1;
    if (multi) bar = xcd_barrier_post((unsigned*)(ws0 + WS_CTL) + CW_BAR, MISC + 8);
#define IN(k) (KSEL < 0 ? (lo <= (k) && (k) < hi) : (KSEL == 100 ? (k) == 0 : ((k) > 0 && KSEL == ((k) - 1) % NPH_LAYER && (k) == lo)))
#define SITE Ctx C = C0; { int t_ = threadIdx.x; asm volatile("" : "+v"(t_)); C.tid = t_; C.lane = t_ & 63; } ArgsP a = args_ptr(); unsigned char* ws = wsp(a); const bf16_t* XB = (const bf16_t*)(ws + WS_XB); bf16_t* Z = (bf16_t*)(ws + WS_Z); bf16_t* Y = (bf16_t*)(ws + WS_Y); (void)XB; (void)Z; (void)Y; (void)a
#define MOEP const unsigned* cnt = (const unsigned*)(ws + WS_CTL) + CW_CNT; const int* list = (const int*)(ws + WS_LIST); const float* glist = (const float*)(ws + WS_GLIST); (void)glist
#define INJ(j) (KSEL < 0 ? (lo <= pb + (j) && pb + (j) < hi) : (KSEL == (j) && lo == pb + (j)))
#define SEAM(k) do { if (KSEL < 0) { if (multi && (k) + 1 < hi) xcd_barrier(bar); } } while (0)
    if (IN(0)) { Ctx C = C0; { int t_ = threadIdx.x; asm volatile("" : "+v"(t_)); C.tid = t_; C.lane = t_ & 63; } ArgsP a = args_ptr(); phase_prologue(C, a); SEAM(0); }
#pragma unroll 1
    for (int l = 0; l < 2; ++l) {
        const int pb = 1 + NPH_LAYER * l;
        if (INJ(0)) { SITE;
            pg8::Gemm g{XB, (const bf16_t*)(ws + WS_WIN) + (size_t)l * DINP * DM, DM, DM, DM}; pg8::StaticOrder S; S.init(NTOK, DINP, C.G, C.blk, DM, DM);
            EpiStore E{Z, DINP, nullptr};
            pg8::gemm_phase<EpiStore, pg8::StaticOrder, true, false>(C.lds, g, S, E);
            SEAM(pb + 0);
        }
        if (INJ(1)) { SITE; phase_tokenlocal(C, a, l); SEAM(pb + 1); }
        if (INJ(2)) { SITE;
#if !defined(UPSEL) || UPSEL == 1
            { pg8::Gemm g{(const bf16_t*)(ws + WS_CQN), (const bf16_t*)(ws + WS_WUQ) + (size_t)l * QW * QRANK, QRANK, QRANK, QRANK}; pg8::StaticOrder S; S.init(NTOK, QW, C.G, C.blk, QRANK, QRANK);
              EpiQ E{(bf16_t*)(ws + WS_Q), (const f32x2*)(ws + WS_ROPE)};
              pg8::gemm_phase<EpiQ, pg8::StaticOrder, true, false>(C.lds, g, S, E); }
#endif
#if !defined(UPSEL) || UPSEL == 2
            { pg8::Gemm g{(const bf16_t*)(ws + WS_CKVN), (const bf16_t*)(ws + WS_WK) + (size_t)l * 512 * KVRANK, KVRANK, KVRANK, KVRANK}; pg8::StaticOrder S; S.init(NTOK, 512, C.G, C.blk, KVRANK, KVRANK);
              EpiStore E{(bf16_t*)(ws + WS_KN), 512, nullptr};
              pg8::gemm_phase<EpiStore, pg8::StaticOrder, true, false>(C.lds, g, S, E); }
#endif
#if !defined(UPSEL) || UPSEL == 3
            { pg8::Gemm g{(const bf16_t*)(ws + WS_WV) + (size_t)l * 512 * KVRANK, (const bf16_t*)(ws + WS_CKVN), KVRANK, KVRANK, KVRANK}; pg8::StaticOrder S; S.init(512, NTOK, C.G, C.blk, KVRANK, KVRANK);
              EpiVT E{(bf16_t*)(ws + WS_VT)};
              pg8::gemm_phase<EpiVT, pg8::StaticOrder, true, false>(C.lds, g, S, E); }
#endif
            SEAM(pb + 2);
        }
        if (INJ(3)) { SITE;
            for (int u = C.blk; u < NBATCH * LRU_NCH; u += C.G)
                lru::lru_unit<2>(u / LRU_NCH, u % LRU_NCH, l, Z, (const bf16_t*)(ws + WS_LRUW), (const float*)(ws + WS_C8SP), a->in[I_LCW], a->in[I_LCB], a->in[I_LBA], a->in[I_LBI],
                                 (float*)(ws + WS_AGGA), (float*)(ws + WS_AGGH), a->in[I_MIXG] + (size_t)l * DM + 768, Y, C.lds);
            const int nun = NBATCH * 8 * (SEQ / 256);
            for (int i = 0; ; ++i) {
                int bh, qb;
                if (C.G == 256) { if (i >= 4) break; bh = i * 8 + (C.blk & 7); qb = C.blk >> 3; }
                else { const int L = i * C.G + C.blk; if (L >= nun) break; bh = L >> 5; qb = L & 31; }
                att::attn_unit(bh >> 3, bh & 7, qb, (const bf16_t*)(ws + WS_Q), (const bf16_t*)(ws + WS_KN), (const bf16_t*)(ws + WS_KR), (const bf16_t*)(ws + WS_VT), Y, C.lds);
            }
            SEAM(pb + 3);
        }
        if (INJ(4)) { SITE; phase_mlanorm(C, a, l); SEAM(pb + 4); }
        if (INJ(5)) { SITE;
            pg8::Gemm g{Y, (const bf16_t*)(ws + WS_WOUT) + (size_t)l * DM * DM, DM, DM, DM}; pg8::StaticOrder S; S.init(NTOK, DM, C.G, C.blk, DM, DM);
            EpiResid E{a->out};
            pg8::gemm_phase<EpiResid, pg8::StaticOrder, true, false>(C.lds, g, S, E);
            SEAM(pb + 5);
        }
        if (INJ(6)) { SITE;
            if (l == 0) phase_ln<false>(C, a, a->in[I_LN1G] + (size_t)l * DM, a->in[I_LN1B] + (size_t)l * DM);
            else phase_ln<true>(C, a, a->in[I_LN1G] + (size_t)l * DM, a->in[I_LN1B] + (size_t)l * DM);
            SEAM(pb + 6);
        }
        if (l == 0) {
            if (INJ(7)) { SITE;
                pg8::Gemm g{XB, (const bf16_t*)(ws + WS_WGU), DM, DM, DM}; pg8::StaticOrder S; S.init(NTOK, 2 * DFF, C.G, C.blk, DM, DM);
                EpiSwiglu E{(bf16_t*)(ws + WS_H)};
                pg8::gemm_phase<EpiSwiglu, pg8::StaticOrder, true, false>(C.lds, g, S, E);
                SEAM(pb + 7);
            }
            if (INJ(8)) { SITE;
                pg8::Gemm g{(const bf16_t*)(ws + WS_H), (const bf16_t*)(ws + WS_WD), DFF, DFF, DFF}; pg8::StaticOrder S; S.init(NTOK, DM, C.G, C.blk, DFF, DFF);
                EpiResid E{a->out};
                pg8::gemm_phase<EpiResid, pg8::StaticOrder, true, false>(C.lds, g, S, E);
                SEAM(pb + 8);
            }
        } else {
#pragma unroll
            for (int p = 0; p < 2; ++p) {
                if (INJ(7 + 2 * p)) { SITE; MOEP;
                    pg8::Gemm g{XB, (const bf16_t*)(ws + WS_WGUM), DM, DM, DM}; pg8::MoeOrder S; S.init(cnt, p, 2 * DFF / 256, C.G, C.blk, list, 0, DM, DM, (size_t)2 * DFF * DM * 2);
                    EpiSwiglu E{(bf16_t*)(ws + WS_HM)};
                    pg8::gemm_phase<EpiSwiglu, pg8::MoeOrder, true, true>(C.lds, g, S, E);
                    SEAM(pb + 7 + 2 * p);
                }
                if (INJ(8 + 2 * p)) { SITE; MOEP;
                    pg8::Gemm g{(const bf16_t*)(ws + WS_HM), (const bf16_t*)(ws + WS_WDM), DFF, DFF, DFF}; pg8::MoeOrder S; S.init(cnt, p, DM / 256, C.G, C.blk, list, 1, DFF, DFF, (size_t)DM * DFF * 2);
                    EpiMoeDown E{a->out, list, glist, p};
                    pg8::gemm_phase<EpiMoeDown, pg8::MoeOrder, true, false>(C.lds, g, S, E);
                    SEAM(pb + 8 + 2 * p);
                }
            }
        }
        if (INJ(11)) { SITE; phase_ln<false>(C, a, a->in[I_LN2G] + (size_t)l * DM, a->in[I_LN2B] + (size_t)l * DM); SEAM(pb + 11); }
    }
#undef IN
#undef INJ
#undef SITE
#undef MOEP
#undef SEAM
}

#if MEGA
constexpr int NKERN = 1;
static const void* kern_tab(int) { return (const void*)fwd_kernel<-1>; }
#else
constexpr int NKERN = 13;
static const void* kern_tab(int k) {
    switch (k) { case 0: return (const void*)fwd_kernel<0>; case 1: return (const void*)fwd_kernel<1>; case 2: return (const void*)fwd_kernel<2>; case 3: return (const void*)fwd_kernel<3>;
        case 4: return (const void*)fwd_kernel<4>; case 5: return (const void*)fwd_kernel<5>; case 6: return (const void*)fwd_kernel<6>; case 7: return (const void*)fwd_kernel<7>;
        case 8: return (const void*)fwd_kernel<8>; case 9: return (const void*)fwd_kernel<9>; case 10: return (const void*)fwd_kernel<10>; case 11: return (const void*)fwd_kernel<11>;
        default: return (const void*)fwd_kernel<100>; }
}
#endif
extern "C" void kernel_launch(void* const* d_in, const int* in_sizes, int n_in, void* d_out, int out_size, void* d_ws, size_t ws_size, hipStream_t stream) {
    static int grid = 0;
    if (grid == 0) {
        if (n_in != 29 || in_sizes[0] != NTOK * DM || out_size != NTOK * DM || ws_size < WS_END) { fprintf(stderr, "kernel_launch: unexpected shapes / workspace (%d inputs, ws %zu < %zu)\n", n_in, ws_size, (size_t)WS_END); grid = -1; return; }
        int dev = 0, cus = 0, per_cu = 0;
        if (hipGetDevice(&dev) != hipSuccess || hipDeviceGetAttribute(&cus, hipDeviceAttributeMultiprocessorCount, dev) != hipSuccess) { grid = -1; return; }
        for (int k = 0; k < NKERN; ++k) if (hipFuncSetAttribute(kern_tab(k), hipFuncAttributeMaxDynamicSharedMemorySize, LDS_BYTES) != hipSuccess) { fprintf(stderr, "kernel_launch: hipFuncSetAttribute failed\n"); grid = -1; return; }
        if (hipOccupancyMaxActiveBlocksPerMultiprocessor(&per_cu, kern_tab(0), 512, LDS_BYTES) != hipSuccess || per_cu < 1) { fprintf(stderr, "kernel_launch: occupancy query says %d\n", per_cu); }
        (void)hipGetLastError();
        grid = cus;
    }
    if (grid < 0) return;
    (void)hipMemsetAsync((char*)d_ws + WS_CTL, 0, CTL_ZERO_BYTES, stream);
    Args a{};
    for (int i = 0; i < 29; ++i) a.in[i] = (const float*)d_in[i];
    a.out = (float*)d_out; a.ws = (unsigned char*)d_ws;
#if MEGA
    a.ph_lo = 0; a.ph_hi = NPHASES;
    hipLaunchKernelGGL(fwd_kernel<-1>, dim3(grid), dim3(512), LDS_BYTES, stream, a);
#else
    for (int ph = 0; ph < NPHASES; ++ph) {
        if (ph == 1 + 9 || ph == 1 + 10) continue;
        a.ph_lo = ph; a.ph_hi = ph + 1;
        void* args[] = {&a};
        (void)hipLaunchKernel(kern_tab(ph == 0 ? 12 : (ph - 1) % NPH_LAYER), dim3(grid), dim3(512), args, LDS_BYTES, stream);
    }
#endif
}
```

```cpp
#include <hip/hip_runtime.h>
#include <cstdio>
#include <cstdint>
#include <cmath>

#define LAS __attribute__((address_space(3)))
#define GAS __attribute__((address_space(1)))
typedef unsigned short bf16_t;
typedef short bf16x8 __attribute__((ext_vector_type(8)));
typedef float f32x4 __attribute__((ext_vector_type(4)));
typedef float f32x2 __attribute__((ext_vector_type(2)));
typedef float f32x16 __attribute__((ext_vector_type(16)));
typedef unsigned u32x4 __attribute__((ext_vector_type(4)));
typedef unsigned u32x2 __attribute__((ext_vector_type(2)));

#ifndef PROBE_REPEAT
#define PROBE_REPEAT 0
#endif
#ifndef MEGA
#define MEGA 1
#endif

constexpr int NTOK = 32768, SEQ = 8192, NBATCH = 4, DM = 1024, DIN = 1952, DINP = 2048, DFF = 3584, NEXP = 8;
constexpr int ZC_B = 0, ZC_C = 256, ZC_H = 512, ZC_Q = 768, ZC_KV = 1152, ZC_KR = 1408, ZC_LG = 1440, ZC_LX = 1696;
constexpr int QW = 768, QRANK = 384, KVRANK = 256;
constexpr float DN_ALPHA = 1.41421356237309515f;
constexpr float LN_EPS = 1e-5f, RMS_EPS = 1e-6f;
constexpr float QSCALE = 0.10206207261596575f * 1.4426950408889634f;
constexpr int LRU_CH = 128, LRU_NCH = SEQ / LRU_CH;

constexpr size_t MiB = 1u << 20;
constexpr size_t WS_CTL = 0, CTL_ZERO_BYTES = 65536;
constexpr size_t WS_ROPE = 1 * MiB;
constexpr size_t WS_RSQ = 2 * MiB, WS_RSKV = 2 * MiB + 131072;
constexpr size_t WS_AGGA = 3 * MiB, WS_AGGH = 3 * MiB + 524288;
constexpr size_t WS_TOKE = 4 * MiB, WS_TOKR = 4 * MiB + 262144, WS_TOKG = 4 * MiB + 524288;
constexpr size_t WS_LIST = 5 * MiB, WS_GLIST = 7 * MiB;
constexpr size_t WS_LRUW = 9 * MiB, WS_C8SP = 9 * MiB + 262144;
constexpr size_t WS_WIN = 10 * MiB, WS_WUQ = 18 * MiB, WS_WK = 20 * MiB, WS_WV = 20 * MiB + 524288, WS_WOUT = 21 * MiB, WS_WGU = 25 * MiB, WS_WD = 39 * MiB;
constexpr size_t WS_XB = 46 * MiB;
constexpr size_t WS_R = 110 * MiB;
constexpr size_t WS_Z = WS_R, WS_Q = WS_R + 128 * MiB, WS_KN = WS_R + 176 * MiB, WS_KR = WS_R + 208 * MiB, WS_VT = WS_R + 210 * MiB, WS_Y = WS_R + 242 * MiB;
constexpr size_t WS_CQN = WS_R + 306 * MiB, WS_CKVN = WS_R + 330 * MiB;
constexpr size_t WS_H = WS_R;
constexpr size_t WS_WGUM = WS_R, WS_WDM = WS_R + 112 * MiB, WS_HM = WS_R + 168 * MiB;
constexpr size_t WS_END = WS_R + 394 * MiB;
constexpr int CW_TMO = 0, CW_BAR = 4096, CW_CNT = 8192;

constexpr int RING_BYTES = 131072, MISC_OFF = RING_BYTES, LDS_BYTES = 147456;

__device__ __forceinline__ unsigned f2bf(float f) { unsigned u = __builtin_bit_cast(unsigned, f); return (u + 0x7fffu + ((u >> 16) & 1u)) >> 16; }
__device__ __forceinline__ unsigned pk2(float lo, float hi) { unsigned r; asm volatile("v_cvt_pk_bf16_f32 %0, %1, %2" : "=v"(r) : "v"(lo), "v"(hi)); return r; }
__device__ __forceinline__ float bf2f(unsigned short b) { return __builtin_bit_cast(float, (unsigned)b << 16); }
__device__ __forceinline__ float bflo(unsigned w) { return __builtin_bit_cast(float, w << 16); }
__device__ __forceinline__ float bfhi(unsigned w) { return __builtin_bit_cast(float, w & 0xffff0000u); }
__device__ __forceinline__ float wave_sum(float v) {
#pragma unroll
    for (int o = 1; o < 64; o <<= 1) v += __shfl_xor(v, o);
    return v;
}
__device__ __forceinline__ float sigmoidf_(float x) { return 1.0f / (1.0f + __expf(-x)); }
__device__ __forceinline__ float gelu_tanh(float x) { const float u = 0.7978845608028654f * (x + 0.044715f * x * x * x); return 0.5f * x * (1.0f + tanhf(u)); }
#define LDS_WAIT() asm volatile("s_waitcnt lgkmcnt(0)" ::: "memory")
#define VM_WAIT() asm volatile("s_waitcnt vmcnt(0)" ::: "memory")

namespace pg8 {
constexpr int BM = 256, BK = 64, HALF = 128, HTB = HALF * BK * 2, STAGE_BYTES = 8 * HTB, NXCD = 8, WGM = 8;
__host__ __device__ __forceinline__ int lds_byte(int r, int c) { const int st = (r >> 4) * 2 + (c >> 5), rr = r & 15, cc = c & 31, ob = rr * 64 + cc * 2; return st * 1024 + (ob ^ (((ob >> 9) & 1) << 5)); }
__host__ __device__ __forceinline__ void stage_rc(int b, int& R, int& C) { const int st = b / 1024, sb = b % 1024, swz = sb ^ (((sb >> 9) & 1) << 5); R = (st >> 1) * 16 + swz / 64; C = (st & 1) * 32 + (swz % 64) / 2; }
__host__ __device__ __forceinline__ int perm32(int rho) { const int n = rho >> 4, i = rho & 15; return 8 * (i >> 2) + 4 * n + (i & 3); }

struct Unit { int pm, pn, e, valid, rowbase, lbase; };
struct Gemm { const bf16_t* A; const bf16_t* Bt; int lda, ldb, K; };

struct StaticOrder {
    int nM, nN, nwg, G, c; size_t astep, bstep;
    __device__ void init(int M, int N, int G_, int c_, int lda, int ldb) { nM = M / BM; nN = N / BM; nwg = nM * nN; G = G_; c = c_; astep = (size_t)BM * lda * 2; bstep = (size_t)BM * ldb * 2; }
    __device__ bool next(int i, Unit& u) const {
        const long L = (long)i * G + c; if (L >= nwg) return false;
        int wgid = (int)L; { const int q = nwg / NXCD, r = nwg % NXCD, xcd = wgid % NXCD, off = wgid / NXCD; wgid = (xcd < r ? xcd * (q + 1) : r * (q + 1) + (xcd - r) * q) + off; }
        const int nig = WGM * nN, gid = wgid / nig, fm = gid * WGM, gsz = (nM - fm) < WGM ? (nM - fm) : WGM;
        u.pm = fm + ((wgid % nig) % gsz); u.pn = (wgid % nig) / gsz; u.e = 0; u.valid = 256; u.rowbase = u.pm * BM; u.lbase = 0; return true;
    }
    __device__ __forceinline__ size_t a_off(const Unit& u) const { return (size_t)u.pm * astep; }
    __device__ __forceinline__ size_t b_off(const Unit& u) const { return (size_t)u.pn * bstep; }
    __device__ __forceinline__ int row_tok(const Unit&, int) const { return 0; }
};

struct MoeOrder {
    int G, c, nN, pass; const unsigned* counts; const int* list; size_t bexp, bstep, astep;
    __device__ void init(const unsigned* counts_, int pass_, int nN_, int G_, int c_, const int* list_, int, int lda, int ldb, size_t bexp_) {
        G = G_; c = c_; nN = nN_; pass = pass_; list = list_; counts = counts_ + pass_ * 8; bexp = bexp_; bstep = (size_t)BM * ldb * 2; astep = (size_t)lda * 2;
    }
    __device__ bool next(int i, Unit& u) const {
        const int L = i * G + c;
        int e = -1, c0 = 0, np = 1, cn = 0, s0 = 0, a = 0, s = 0;
#pragma unroll
        for (int k = 0; k < 8; ++k) { const int n = __builtin_amdgcn_readfirstlane((int)__hip_atomic_load(counts + k, __ATOMIC_RELAXED, __HIP_MEMORY_SCOPE_AGENT)); const int npk = (n + 255) >> 8;
            if (L >= a * nN && L < (a + npk) * nN) { e = k; c0 = a; np = npk; cn = n; s0 = s; }
            a += npk; s += n; }
        if (e < 0) return false;
        const int le = L - c0 * nN; const int pn = le / np, j = le % np;
        u.e = e; u.pn = pn; u.pm = j; u.valid = (cn - 256 * j) < 256 ? (cn - 256 * j) : 256; u.rowbase = s0 + 256 * j; u.lbase = (pass * 8 + e) * NTOK + 256 * j; return true;
    }
    __device__ __forceinline__ size_t a_off(const Unit& u) const { return (size_t)u.rowbase * astep; }
    __device__ __forceinline__ size_t b_off(const Unit& u) const { return (size_t)u.e * bexp + (size_t)u.pn * bstep; }
    __device__ __forceinline__ int row_tok(const Unit& u, int R) const { return (R < u.valid) ? list[u.lbase + R] : 0; }
};

template <class Epi, class Sched, bool ALIGN_EPI, bool GATHER>
__device__ __forceinline__ void gemm_phase(LAS unsigned char* lds, const Gemm g, const Sched& S, const Epi& E) {
    int tid_ = threadIdx.x; asm volatile("" : "+v"(tid_));
    const int tid = tid_, wid = __builtin_amdgcn_readfirstlane(tid >> 6), lane = tid & 63, wr = wid >> 2, wc = wid & 3, fr = lane & 15, fq = lane >> 4;
    const int K = g.K, nt = K / BK;
    unsigned voffA[2], voffB[2]; int RA0, CA0;
#pragma unroll
    for (int i = 0; i < 2; ++i) { int R, C; stage_rc(tid * 16 + i * 8192, R, C); const int Rb = Epi::PERM ? ((R & ~31) + perm32(R & 31)) : R;
        if (i == 0) { RA0 = R; CA0 = C; } voffA[i] = (unsigned)(R * g.lda + C) * 2u; voffB[i] = (unsigned)(Rb * g.ldb + C) * 2u; }
    LAS int* tokt = (LAS int*)(lds + STAGE_BYTES + 1024);
    const size_t kstep = (size_t)(BK * 2);
    const size_t hstepA = GATHER ? 0 : (size_t)HALF * g.lda * 2, hstepB = (size_t)HALF * g.ldb * 2;
    const unsigned ldsw = (unsigned)wid * 1024u;
    const int aoff = lds_byte(wr * 64 + fr, fq * 8), boff = lds_byte(wc * 32 + fr, fq * 8);
#define PG8_SA(b, h) (((b) * 2 + (h)) * HTB)
#define PG8_SB(b, h) ((4 + (b) * 2 + (h)) * HTB)
#define PG8_STAGE(bufoff, gbase, v0, v1) do { \
        __builtin_amdgcn_global_load_lds((const unsigned*)((const char*)(gbase) + (v0)), (LAS unsigned*)(lds + (bufoff) + ldsw), 16, 0, 0); \
        __builtin_amdgcn_global_load_lds((const unsigned*)((const char*)(gbase) + (v1)), (LAS unsigned*)(lds + (bufoff) + ldsw + 8192), 16, 0, 0); } while (0)
#define PG8_STAGEB(bufoff, gbase) PG8_STAGE(bufoff, gbase, voffB[0], voffB[1])
#define PG8_STAGEA(bufoff, gbase, h, nx) do { if constexpr (GATHER) { const LAS int* tt_ = tokt + (((ui + ((nx) ? 1 : 0)) & 1) << 8) + (h) * HALF + RA0; \
            const unsigned o0_ = (unsigned)tt_[0] * (unsigned)(g.lda * 2) + (unsigned)(CA0 * 2), o1_ = (unsigned)tt_[64] * (unsigned)(g.lda * 2) + (unsigned)(CA0 * 2); PG8_STAGE(bufoff, gbase, o0_, o1_); } \
        else PG8_STAGE(bufoff, (gbase) + (h) * hstepA, voffA[0], voffA[1]); } while (0)
#define PG8_LDA(dst, b, h) do { _Pragma("unroll") for (int m = 0; m < 4; ++m) _Pragma("unroll") for (int k = 0; k < 2; ++k) dst[m][k] = *(const LAS bf16x8*)(lds + PG8_SA(b, h) + aoff + m * 2048 + k * 1024); } while (0)
#define PG8_LDB(dst, b, h) do { _Pragma("unroll") for (int n = 0; n < 2; ++n) _Pragma("unroll") for (int k = 0; k < 2; ++k) dst[n][k] = *(const LAS bf16x8*)(lds + PG8_SB(b, h) + boff + n * 2048 + k * 1024); } while (0)
#define PG8_MMA(ai, bj, At, Bt) do { __builtin_amdgcn_s_setprio(1); _Pragma("unroll") for (int m = 0; m < 4; ++m) _Pragma("unroll") for (int n = 0; n < 2; ++n) _Pragma("unroll") for (int k = 0; k < 2; ++k) \
        acc[ai][bj][m][n] = __builtin_amdgcn_mfma_f32_16x16x32_bf16(Bt[n][k], At[m][k], acc[ai][bj][m][n], 0, 0, 0); __builtin_amdgcn_s_setprio(0); } while (0)
#define PG8_WAIT_V(n) asm volatile("s_waitcnt vmcnt(" #n ")" ::: "memory")
#define PG8_WAIT_L(n) asm volatile("s_waitcnt lgkmcnt(" #n ")" ::: "memory")
#define PG8_BAR __builtin_amdgcn_s_barrier()
#define PG8_SCHED __builtin_amdgcn_sched_barrier(0)
#define PG8_GTOK(u, slot) do { if constexpr (GATHER) { if (tid < 256) tokt[((slot) & 1) * 256 + tid] = S.row_tok(u, tid); } } while (0)
    Unit cur, nxt; int ui = 0;
    if (!S.next(0, cur)) return;
    f32x4 acc[2][2][4][2];
#pragma unroll
    for (int a = 0; a < 2; ++a)
#pragma unroll
        for (int b = 0; b < 2; ++b)
#pragma unroll
            for (int m = 0; m < 4; ++m)
#pragma unroll
                for (int n = 0; n < 2; ++n) acc[a][b][m][n] = (f32x4){0.f, 0.f, 0.f, 0.f};
    bf16x8 At[4][2], B0[2][2], B1[2][2];
    const char* cA = (const char*)g.A + (GATHER ? (size_t)0 : S.a_off(cur)); const char* cB = (const char*)g.Bt + S.b_off(cur);
    if constexpr (GATHER) { PG8_GTOK(cur, 0); asm volatile("s_waitcnt lgkmcnt(0)" ::: "memory"); __builtin_amdgcn_s_barrier(); asm volatile("" ::: "memory"); }
    PG8_STAGEB(PG8_SB(0, 0), cB); PG8_STAGEB(PG8_SB(0, 1), cB + hstepB); PG8_STAGEA(PG8_SA(0, 0), cA, 0, false); PG8_STAGEA(PG8_SA(0, 1), cA, 1, false);
    if (wr == 1) PG8_BAR;
    PG8_WAIT_V(2); PG8_BAR;
    PG8_STAGEB(PG8_SB(1, 0), cB + kstep); PG8_STAGEA(PG8_SA(1, 0), cA + kstep, 0, false); PG8_STAGEB(PG8_SB(1, 1), cB + hstepB + kstep);
    PG8_WAIT_V(6); PG8_BAR;
    for (;;) {
        const bool has_next = S.next(ui + 1, nxt);
        const char* nA = has_next ? (const char*)g.A + (GATHER ? (size_t)0 : S.a_off(nxt)) : cA; const char* nB = has_next ? (const char*)g.Bt + S.b_off(nxt) : cB;
        if constexpr (GATHER) { if (has_next) PG8_GTOK(nxt, ui + 1); else PG8_GTOK(cur, ui + 1); }
#pragma unroll 1
        for (int t = 0; t < nt; t += 2) {
            const bool last = (t == nt - 2);
            const char* a1 = cA + (size_t)(t + 1) * kstep;
            const char* a2 = last ? nA : cA + (size_t)(t + 2) * kstep; const char* b2 = last ? nB : cB + (size_t)(t + 2) * kstep;
            const char* a3 = a2 + kstep; const char* b3 = b2 + kstep;
            PG8_LDB(B0, 0, 0); PG8_LDB(B1, 0, 1); PG8_SCHED; PG8_LDA(At, 0, 0); PG8_STAGEA(PG8_SA(1, 1), a1, 1, false);
            PG8_WAIT_V(8); PG8_WAIT_L(0); PG8_BAR; PG8_MMA(0, 0, At, B0); PG8_MMA(0, 1, At, B1); PG8_BAR; PG8_SCHED;
            PG8_LDA(At, 0, 1); PG8_STAGEB(PG8_SB(0, 0), b2); PG8_STAGEB(PG8_SB(0, 1), b2 + hstepB); PG8_STAGEA(PG8_SA(0, 0), a2, 0, last);
            PG8_WAIT_V(8); PG8_WAIT_L(0); PG8_BAR; PG8_MMA(1, 0, At, B0); PG8_MMA(1, 1, At, B1); PG8_BAR; PG8_SCHED;
            PG8_LDB(B0, 1, 0); PG8_LDB(B1, 1, 1); PG8_SCHED; PG8_LDA(At, 1, 0); PG8_STAGEA(PG8_SA(0, 1), a2, 1, last);
            PG8_WAIT_V(8); PG8_WAIT_L(0); PG8_BAR; PG8_MMA(0, 0, At, B0); PG8_MMA(0, 1, At, B1); PG8_BAR; PG8_SCHED;
            PG8_LDA(At, 1, 1); PG8_STAGEB(PG8_SB(1, 0), b3); PG8_STAGEB(PG8_SB(1, 1), b3 + hstepB); PG8_STAGEA(PG8_SA(1, 0), a3, 0, last);
            PG8_WAIT_V(8); PG8_WAIT_L(0); PG8_BAR; PG8_MMA(1, 0, At, B0); PG8_MMA(1, 1, At, B1); PG8_BAR; PG8_SCHED;
        }
        if constexpr (ALIGN_EPI) { if (wr == 0) PG8_BAR; }
        E(acc, cur, wr, wc, fr, fq);
        if (!has_next) break;
#pragma unroll
        for (int a = 0; a < 2; ++a)
#pragma unroll
            for (int b = 0; b < 2; ++b)
#pragma unroll
                for (int m = 0; m < 4; ++m)
#pragma unroll
                    for (int n = 0; n < 2; ++n) acc[a][b][m][n] = (f32x4){0.f, 0.f, 0.f, 0.f};
        cur = nxt; cA = nA; cB = nB; ++ui;
        if constexpr (ALIGN_EPI) { if (wr == 1) PG8_BAR; }
    }
    PG8_WAIT_V(0);
    if constexpr (!ALIGN_EPI) { if (wr == 0) PG8_BAR; }
    PG8_BAR;
#undef PG8_SA
#undef PG8_SB
#undef PG8_STAGE
#undef PG8_STAGEA
#undef PG8_STAGEB
#undef PG8_LDA
#undef PG8_LDB
#undef PG8_MMA
#undef PG8_WAIT_V
#undef PG8_WAIT_L
#undef PG8_BAR
#undef PG8_SCHED
#undef PG8_GTOK
}
}
using pg8::Unit;

typedef f32x4 Acc[2][2][4][2];
struct EpiStore {
    static constexpr bool PERM = true;
    bf16_t* O; int ldc; const float* rowscale;
    __device__ __forceinline__ void operator()(Acc& acc, const Unit& u, int wr, int wc, int fr, int fq) const {
        const int row0 = u.pm * 256 + wr * 64 + fr, col0 = u.pn * 256 + wc * 32 + 8 * fq;
#pragma unroll
        for (int ai = 0; ai < 2; ++ai)
#pragma unroll
            for (int m = 0; m < 4; ++m) { const int row = row0 + ai * 128 + m * 16; const float s = rowscale ? rowscale[row] : 1.f;
                asm volatile("" : "+v"(acc[ai][0][m][0]), "+v"(acc[ai][0][m][1]), "+v"(acc[ai][1][m][0]), "+v"(acc[ai][1][m][1])); bf16_t* rowp = O + ((unsigned)row * (unsigned)ldc + (unsigned)col0);
#pragma unroll
                for (int bj = 0; bj < 2; ++bj) { const f32x4 v0 = acc[ai][bj][m][0] * s, v1 = acc[ai][bj][m][1] * s;
                    u32x4 w; w.x = pk2(v0[0], v0[1]); w.y = pk2(v0[2], v0[3]); w.z = pk2(v1[0], v1[1]); w.w = pk2(v1[2], v1[3]);
                    *(u32x4*)(rowp + bj * 128) = w; } }
    }
};
struct EpiQ {
    static constexpr bool PERM = false;
    bf16_t* Q; const f32x2* rope;
    __device__ __forceinline__ void operator()(Acc& acc, const Unit& u, int wr, int wc, int fr, int fq) const {
#pragma unroll
        for (int ai = 0; ai < 2; ++ai)
#pragma unroll
            for (int m = 0; m < 4; ++m) { const int row = u.pm * 256 + ai * 128 + wr * 64 + m * 16 + fr; const int pos = row & (SEQ - 1);
                asm volatile("" : "+v"(acc[ai][0][m][0]), "+v"(acc[ai][0][m][1]), "+v"(acc[ai][1][m][0]), "+v"(acc[ai][1][m][1]));
                const f32x4 t0 = *(const f32x4*)(rope + ((unsigned)pos * 16u + 4u * fq)), t1 = *(const f32x4*)(rope + ((unsigned)pos * 16u + 4u * fq + 2u));
                const float cs[4] = {t0[0], t0[2], t1[0], t1[2]}, sn[4] = {t0[1], t0[3], t1[1], t1[3]};
#pragma unroll
                for (int bj = 0; bj < 2; ++bj) { const int cg = u.pn * 256 + bj * 128 + wc * 32; const bool isrope = ((cg >> 5) % 3) == 2;
                    f32x4 v0 = acc[ai][bj][m][0], v1 = acc[ai][bj][m][1];
                    if (isrope) {
#pragma unroll
                        for (int e = 0; e < 4; ++e) { const float x1 = v0[e], x2 = v1[e]; v0[e] = x1 * cs[e] - x2 * sn[e]; v1[e] = x2 * cs[e] + x1 * sn[e]; } }
                    u32x2 w0, w1; w0.x = pk2(v0[0], v0[1]); w0.y = pk2(v0[2], v0[3]); w1.x = pk2(v1[0], v1[1]); w1.y = pk2(v1[2], v1[3]);
                    bf16_t* p = Q + ((unsigned)row * (unsigned)QW + (unsigned)(cg + 4 * fq)); *(u32x2*)p = w0; *(u32x2*)(p + 16) = w1; }
                asm volatile("" ::: "memory"); }
    }
};
struct EpiVT {
    static constexpr bool PERM = true;
    bf16_t* VT;
    __device__ __forceinline__ void operator()(Acc& acc, const Unit& u, int wr, int wc, int fr, int fq) const {
#pragma unroll
        for (int bj = 0; bj < 2; ++bj) { const int tb = u.pn * 256 + bj * 128 + wc * 32 + 8 * fq; const int base16 = tb & ~15, c = (tb >> 3) & 1;
#pragma unroll
            for (int ai = 0; ai < 2; ++ai)
#pragma unroll
                for (int m = 0; m < 4; ++m) { const int f = u.pm * 256 + ai * 128 + wr * 64 + m * 16 + fr; asm volatile("" : "+v"(acc[ai][bj][m][0]), "+v"(acc[ai][bj][m][1])); const f32x4 v0 = acc[ai][bj][m][0], v1 = acc[ai][bj][m][1];
                    u32x2 w0, w1; w0.x = pk2(v0[0], v0[1]); w0.y = pk2(v0[2], v0[3]); w1.x = pk2(v1[0], v1[1]); w1.y = pk2(v1[2], v1[3]);
                    bf16_t* p = VT + ((unsigned)f * (unsigned)NTOK + (unsigned)(base16 + 4 * c)); *(u32x2*)p = w0; *(u32x2*)(p + 8) = w1; asm volatile("" ::: "memory"); } }
    }
};
struct EpiResid {
    static constexpr bool PERM = false;
    float* X;
    __device__ __forceinline__ void operator()(Acc& acc, const Unit& u, int wr, int wc, int fr, int fq) const {
        const int col0 = u.pn * 256 + wc * 32 + 4 * fq;
#pragma unroll
        for (int ai = 0; ai < 2; ++ai)
#pragma unroll
            for (int m = 0; m < 4; ++m) { const int row = u.pm * 256 + ai * 128 + wr * 64 + m * 16 + fr; float* rp = X + ((unsigned)row * (unsigned)DM + (unsigned)col0);
#pragma unroll
                for (int bj = 0; bj < 2; ++bj)
#pragma unroll
                    for (int n = 0; n < 2; ++n) { f32x4* p = (f32x4*)(rp + bj * 128 + n * 16); const f32x4 x = *p; *p = x * DN_ALPHA + acc[ai][bj][m][n]; } }
    }
};
struct EpiSwiglu {
    static constexpr bool PERM = true;
    bf16_t* H;
    __device__ __forceinline__ void operator()(Acc& acc, const Unit& u, int wr, int wc, int fr, int fq) const {
        const int colh = u.pn * 128 + wc * 32 + 8 * fq;
#pragma unroll
        for (int ai = 0; ai < 2; ++ai)
#pragma unroll
            for (int m = 0; m < 4; ++m) { const int rt = ai * 128 + wr * 64 + m * 16 + fr;
                asm volatile("" : "+v"(acc[ai][0][m][0]), "+v"(acc[ai][0][m][1]), "+v"(acc[ai][1][m][0]), "+v"(acc[ai][1][m][1]));
                float hv[8];
#pragma unroll
                for (int n = 0; n < 2; ++n)
#pragma unroll
                    for (int e = 0; e < 4; ++e) { const float g = acc[ai][0][m][n][e], up = acc[ai][1][m][n][e]; hv[4 * n + e] = g * __builtin_amdgcn_rcpf(1.0f + __expf(-g)) * up; }
                u32x4 w; w.x = pk2(hv[0], hv[1]); w.y = pk2(hv[2], hv[3]); w.z = pk2(hv[4], hv[5]); w.w = pk2(hv[6], hv[7]);
                if (rt < u.valid) *(u32x4*)(H + ((unsigned)(u.rowbase + rt) * (unsigned)DFF + (unsigned)colh)) = w; asm volatile("" ::: "memory"); }
    }
};
struct EpiMoeDown {
    static constexpr bool PERM = false;
    float* X; const int* list; const float* glist; int pass;
    __device__ __forceinline__ void operator()(Acc& acc, const Unit& u, int wr, int wc, int fr, int fq) const {
        const int col0 = u.pn * 256 + wc * 32 + 4 * fq; const float al = pass == 0 ? DN_ALPHA : 1.0f;
#pragma unroll
        for (int ai = 0; ai < 2; ++ai)
#pragma unroll
            for (int m = 0; m < 4; ++m) { const int rt = ai * 128 + wr * 64 + m * 16 + fr;
                if (rt < u.valid) { const int tok = list[u.lbase + rt]; const float gt = glist[u.lbase + rt]; float* rp = X + ((unsigned)tok * (unsigned)DM + (unsigned)col0);
#pragma unroll
                    for (int bj = 0; bj < 2; ++bj)
#pragma unroll
                        for (int n = 0; n < 2; ++n) { f32x4* p = (f32x4*)(rp + bj * 128 + n * 16); const f32x4 x = *p; *p = x * al + acc[ai][bj][m][n] * gt; } } }
    }
};

namespace att {
constexpr int KVB = 64, NT = SEQ / KVB, STG = 20480, NSTG = 4;
typedef __bf16 bf16x2_t __attribute__((ext_vector_type(2)));
__device__ __forceinline__ void glds16(const void* gsrc, unsigned lds_dst) { unsigned keep;
    asm volatile("s_mov_b32 %0, m0\n\ts_mov_b32 m0, %2\n\ts_nop 0\n\tglobal_load_lds_dwordx4 %1, off\n\ts_mov_b32 m0, %0" : "=&s"(keep) : "v"(gsrc), "s"(lds_dst) : "memory"); }
__device__ __forceinline__ void attn_unit(int b, int h, int qb, const bf16_t* Q, const bf16_t* Kn, const bf16_t* Kr, const bf16_t* VT, bf16_t* Y, LAS unsigned char* lds) {
    int tid_ = threadIdx.x; asm volatile("" : "+v"(tid_));
    const int tid = tid_, lane = tid & 63, r32 = lane & 31, hi = lane >> 5; const int wid = __builtin_amdgcn_readfirstlane(tid >> 6);
    const size_t rowbase = (size_t)b * SEQ; const int q0 = qb * 256 + wid * 32;
    bf16x8 qf[6];
    { const bf16_t* qp = Q + (rowbase + q0 + r32) * QW + h * 96 + hi * 8;
#pragma unroll
      for (int d0 = 0; d0 < 6; ++d0) qf[d0] = *(const bf16x8*)(qp + d0 * 16); }
    const char* s0 = (const char*)(Kn + (rowbase + lane) * 512 + h * 64 + wid * 8);
    const char* s1; const char* s2; size_t st1;
    if (wid < 4) { s1 = (const char*)(Kr + (rowbase + lane) * 32 + wid * 8); st1 = (size_t)KVB * 32 * 2;
                   s2 = (const char*)(VT + (size_t)(h * 64 + 32 + r32) * NTOK + rowbase + wid * 16 + hi * 8); }
    else { s1 = (const char*)(VT + (size_t)(h * 64 + r32) * NTOK + rowbase + (wid - 4) * 16 + hi * 8); st1 = (size_t)KVB * 2; s2 = s1; }
    const size_t st0 = (size_t)KVB * 512 * 2, st2 = (size_t)KVB * 2;
    const unsigned lds0 = (unsigned)(uintptr_t)lds;
    const unsigned d0off = (unsigned)wid * 1024u, d1off = (wid < 4) ? (unsigned)(8 + wid) * 1024u : (unsigned)(12 + wid - 4) * 1024u, d2off = (unsigned)(16 + wid) * 1024u;
#define ATT_DMA(t, stg) do { const unsigned sb_ = lds0 + (unsigned)(stg) * STG; \
        glds16(s0 + (size_t)(t) * st0, (unsigned)__builtin_amdgcn_readfirstlane(sb_ + d0off)); \
        glds16(s1 + (size_t)(t) * st1, (unsigned)__builtin_amdgcn_readfirstlane(sb_ + d1off)); \
        if (wid < 4) glds16(s2 + (size_t)(t) * st2, (unsigned)__builtin_amdgcn_readfirstlane(sb_ + d2off)); } while (0)
    float m_run = 0.f, l_run = 0.f; f32x16 o0, o1, negm;
#pragma unroll
    for (int r = 0; r < 16; ++r) { o0[r] = 0.f; o1[r] = 0.f; negm[r] = 0.f; }
    ATT_DMA(0, 0); ATT_DMA(1, 1); ATT_DMA(2, 2);
    if (wid < 4) asm volatile("s_waitcnt vmcnt(6)" ::: "memory"); else asm volatile("s_waitcnt vmcnt(4)" ::: "memory");
    asm volatile("s_barrier" ::: "memory");
    f32x16 p0 = negm, p1 = negm;
#define ATT_QK(P0, P1, Kst) do { _Pragma("unroll") for (int d0 = 0; d0 < 6; ++d0) { \
            const bf16x8 a0_ = *(const LAS bf16x8*)((Kst) + (2 * d0 + hi) * 1024 + r32 * 16); \
            const bf16x8 a1_ = *(const LAS bf16x8*)((Kst) + (2 * d0 + hi) * 1024 + 512 + r32 * 16); \
            P0 = __builtin_amdgcn_mfma_f32_32x32x16_bf16(a0_, qf[d0], P0, 0, 0, 0); \
            P1 = __builtin_amdgcn_mfma_f32_32x32x16_bf16(a1_, qf[d0], P1, 0, 0, 0); } } while (0)
    ATT_QK(p0, p1, lds);
#define MX3(a, b, c) __builtin_fmaxf(__builtin_fmaxf((a), (b)), (c))
#define ATT_MAXFIX(P0, P1, FIRST) do { \
        float ma_ = MX3(P0[0], P0[1], P1[0]), mb_ = MX3(P0[2], P0[3], P1[1]); ma_ = MX3(ma_, P1[2], P1[3]); \
        _Pragma("unroll") for (int r = 4; r < 16; r += 4) { ma_ = MX3(ma_, P0[r], P0[r + 1]); mb_ = MX3(mb_, P0[r + 2], P0[r + 3]); ma_ = MX3(ma_, P1[r], P1[r + 1]); mb_ = MX3(mb_, P1[r + 2], P1[r + 3]); } \
        float mx_ = __builtin_fmaxf(ma_, mb_); \
        { auto rr_ = __builtin_amdgcn_permlane32_swap(__float_as_uint(mx_), __float_as_uint(mx_), false, false); mx_ = __builtin_fmaxf(__uint_as_float(rr_[0]), __uint_as_float(rr_[1])); } \
        if ((FIRST) || __any(mx_ > 8.0f)) { const float dl_ = (FIRST) ? mx_ : __builtin_fmaxf(mx_, 0.f); m_run += dl_; const float al_ = __builtin_amdgcn_exp2f(-dl_); l_run *= al_; \
            _Pragma("unroll") for (int r = 0; r < 16; ++r) { P0[r] -= dl_; P1[r] -= dl_; o0[r] *= al_; o1[r] *= al_; negm[r] = -m_run; } } } while (0)
    ATT_MAXFIX(p0, p1, true);
    int stg = 0;
#pragma unroll 1
    for (int t = 0; t < NT; ++t) {
        if (t + 2 < NT) { if (wid < 4) asm volatile("s_waitcnt vmcnt(3)" ::: "memory"); else asm volatile("s_waitcnt vmcnt(2)" ::: "memory"); }
        else asm volatile("s_waitcnt vmcnt(0)" ::: "memory");
        asm volatile("s_barrier" ::: "memory");
        if (t + 3 < NT) { const int s3 = (stg == 0) ? 3 : stg - 1; ATT_DMA(t + 3, s3); }
        const LAS unsigned char* Ks = lds + stg * STG;
        const LAS unsigned char* Kn1 = lds + ((stg == 3) ? 0 : stg + 1) * STG;
        f32x16 n0 = negm, n1 = negm;
        ATT_QK(n0, n1, Kn1);
        float ls0 = 0.f, ls1 = 0.f;
#pragma unroll
        for (int r = 0; r < 16; ++r) { p0[r] = __builtin_amdgcn_exp2f(p0[r]); p1[r] = __builtin_amdgcn_exp2f(p1[r]); ls0 += p0[r]; ls1 += p1[r]; }
        l_run += ls0 + ls1;
        bf16x8 pb[4];
#define CV2(a, b) __builtin_bit_cast(unsigned, __builtin_convertvector((f32x2){(a), (b)}, bf16x2_t))
        { u32x4 w;
          w.x = CV2(p0[0], p0[1]); w.y = CV2(p0[2], p0[3]); w.z = CV2(p0[4], p0[5]); w.w = CV2(p0[6], p0[7]); pb[0] = __builtin_bit_cast(bf16x8, w);
          w.x = CV2(p0[8], p0[9]); w.y = CV2(p0[10], p0[11]); w.z = CV2(p0[12], p0[13]); w.w = CV2(p0[14], p0[15]); pb[1] = __builtin_bit_cast(bf16x8, w);
          w.x = CV2(p1[0], p1[1]); w.y = CV2(p1[2], p1[3]); w.z = CV2(p1[4], p1[5]); w.w = CV2(p1[6], p1[7]); pb[2] = __builtin_bit_cast(bf16x8, w);
          w.x = CV2(p1[8], p1[9]); w.y = CV2(p1[10], p1[11]); w.z = CV2(p1[12], p1[13]); w.w = CV2(p1[14], p1[15]); pb[3] = __builtin_bit_cast(bf16x8, w); }
#undef CV2
        const LAS unsigned char* Vs = Ks + 12288 + lane * 16;
#pragma unroll
        for (int ks = 0; ks < 4; ++ks) {
            const bf16x8 v0 = *(const LAS bf16x8*)(Vs + ks * 1024);
            const bf16x8 v1 = *(const LAS bf16x8*)(Vs + (4 + ks) * 1024);
            o0 = __builtin_amdgcn_mfma_f32_32x32x16_bf16(v0, pb[ks], o0, 0, 0, 0);
            o1 = __builtin_amdgcn_mfma_f32_32x32x16_bf16(v1, pb[ks], o1, 0, 0, 0);
        }
        p0 = n0; p1 = n1;
        if (t + 1 < NT) ATT_MAXFIX(p0, p1, false);
        stg = (stg == 3) ? 0 : stg + 1;
    }
#undef MX3
#undef ATT_MAXFIX
#undef ATT_QK
#undef ATT_DMA
    const float l = l_run + __shfl_xor(l_run, 32); const float inv = 1.0f / l;
    bf16_t* yp = Y + (rowbase + q0 + r32) * DM + 256 + h * 64 + 4 * hi;
#pragma unroll
    for (int g = 0; g < 4; ++g) {
        u32x2 w0, w1; w0.x = pk2(o0[4 * g] * inv, o0[4 * g + 1] * inv); w0.y = pk2(o0[4 * g + 2] * inv, o0[4 * g + 3] * inv);
        w1.x = pk2(o1[4 * g] * inv, o1[4 * g + 1] * inv); w1.y = pk2(o1[4 * g + 2] * inv, o1[4 * g + 3] * inv);
        *(u32x2*)(yp + 8 * g) = w0; *(u32x2*)(yp + 32 + 8 * g) = w1; }
    asm volatile("s_waitcnt lgkmcnt(0)\n\ts_barrier" ::: "memory");
}
}

namespace lru {
constexpr int HS_BYTES = 65536, WST = 3 * 16 * 36 * 4;
template <int PASS>
__device__ __forceinline__ void lru_unit(int b, int ck, int layer, const bf16_t* Z, const bf16_t* LW, const float* c8sp, const float* convw, const float* convb, const float* ba, const float* bi,
                                         float* aggA, float* aggH, const float* glru, bf16_t* Y, LAS unsigned char* lds) {
    int tid_ = threadIdx.x; asm volatile("" : "+v"(tid_));
    const int tid = tid_, lane = tid & 63, fr = lane & 15, fq = lane >> 4; const int wid = __builtin_amdgcn_readfirstlane(tid >> 6);
    const int n = wid & 3, hf = wid >> 2, chbase = 64 * n, own = chbase + 32 * hf, c = lane & 31;
    LAS float* xs = (LAS float*)(lds + HS_BYTES + wid * WST); LAS float* as_ = xs + 16 * 36; LAS float* us = as_ + 16 * 36;
    LAS bf16_t* hs = (LAS bf16_t*)lds;
    const int tok0 = b * SEQ + ck * LRU_CH;
    float cw[4][16], cb[16];
#pragma unroll
    for (int e = 0; e < 16; ++e) { const int ch = chbase + (e >> 3) * 32 + 8 * fq + (e & 7); cb[e] = convb[layer * 256 + ch];
#pragma unroll
        for (int k = 0; k < 4; ++k) cw[k][e] = convw[(layer * 4 + k) * 256 + ch]; }
#pragma unroll 1
    for (int sweep = 0; sweep < 2; ++sweep) {
        const int d = (PASS == 2) ? 1 - sweep : sweep;
        bf16x8 wf[2][2][2];
#pragma unroll
        for (int g = 0; g < 2; ++g)
#pragma unroll
            for (int nt = 0; nt < 2; ++nt)
#pragma unroll
                for (int ks = 0; ks < 2; ++ks) wf[g][nt][ks] = *(const bf16x8*)(LW + ((size_t)((((layer * 2 + d) * 2 + g) * 4 + n) * 64 + 32 * hf + 16 * nt + fr)) * 64 + ks * 32 + 8 * fq);
        float bav[2][4], biv[2][4], spv[2][4];
#pragma unroll
        for (int nt = 0; nt < 2; ++nt)
#pragma unroll
            for (int e = 0; e < 4; ++e) { const int ch = own + 16 * nt + 4 * fq + e; bav[nt][e] = ba[(layer * 2 + d) * 256 + ch]; biv[nt][e] = bi[(layer * 2 + d) * 256 + ch]; spv[nt][e] = c8sp[(layer * 2 + d) * 256 + ch]; }
        float hst = 0.f, Pa = 1.f;
        if (PASS == 2) {
            const float* pa = aggA + (size_t)((b * 2 + d) * LRU_NCH) * 256 + own + c; const float* ph = aggH + (size_t)((b * 2 + d) * LRU_NCH) * 256 + own + c;
            if (d == 0) { for (int j = 0; j < ck; ++j) hst = pa[(size_t)j * 256] * hst + ph[(size_t)j * 256]; }
            else { for (int j = LRU_NCH - 1; j > ck; --j) hst = pa[(size_t)j * 256] * hst + ph[(size_t)j * 256]; }
        }
#pragma unroll 1
        for (int s = 0; s < 8; ++s) {
            const int sb = (d == 0) ? s : 7 - s; const int t0 = tok0 + sb * 16;
            float xc[16];
#pragma unroll
            for (int e = 0; e < 16; ++e) xc[e] = cb[e];
#pragma unroll
            for (int k = 0; k < 4; ++k) { const int tk = t0 + fr + k - 1; const int pos = tk - b * SEQ;
                if (pos >= 0 && pos < SEQ) { const bf16_t* zp = Z + (size_t)tk * DINP + ZC_LX + chbase + 8 * fq; const u32x4 v0 = *(const u32x4*)zp, v1 = *(const u32x4*)(zp + 32);
                    xc[0] += cw[k][0] * bflo(v0.x); xc[1] += cw[k][1] * bfhi(v0.x); xc[2] += cw[k][2] * bflo(v0.y); xc[3] += cw[k][3] * bfhi(v0.y);
                    xc[4] += cw[k][4] * bflo(v0.z); xc[5] += cw[k][5] * bfhi(v0.z); xc[6] += cw[k][6] * bflo(v0.w); xc[7] += cw[k][7] * bfhi(v0.w);
                    xc[8] += cw[k][8] * bflo(v1.x); xc[9] += cw[k][9] * bfhi(v1.x); xc[10] += cw[k][10] * bflo(v1.y); xc[11] += cw[k][11] * bfhi(v1.y);
                    xc[12] += cw[k][12] * bflo(v1.z); xc[13] += cw[k][13] * bfhi(v1.z); xc[14] += cw[k][14] * bflo(v1.w); xc[15] += cw[k][15] * bfhi(v1.w); } }
            bf16x8 af0, af1;
            { u32x4 w; w.x = pk2(xc[0], xc[1]); w.y = pk2(xc[2], xc[3]); w.z = pk2(xc[4], xc[5]); w.w = pk2(xc[6], xc[7]); af0 = __builtin_bit_cast(bf16x8, w);
              w.x = pk2(xc[8], xc[9]); w.y = pk2(xc[10], xc[11]); w.z = pk2(xc[12], xc[13]); w.w = pk2(xc[14], xc[15]); af1 = __builtin_bit_cast(bf16x8, w); }
            { f32x4 x0, x1;
              if (hf == 0) { x0 = (f32x4){xc[0], xc[1], xc[2], xc[3]}; x1 = (f32x4){xc[4], xc[5], xc[6], xc[7]}; } else { x0 = (f32x4){xc[8], xc[9], xc[10], xc[11]}; x1 = (f32x4){xc[12], xc[13], xc[14], xc[15]}; }
              *(LAS f32x4*)(xs + fr * 36 + 8 * fq) = x0; *(LAS f32x4*)(xs + fr * 36 + 8 * fq + 4) = x1; }
#pragma unroll
            for (int nt = 0; nt < 2; ++nt) {
                f32x4 ga = (f32x4){0.f, 0.f, 0.f, 0.f}, gi = ga;
                ga = __builtin_amdgcn_mfma_f32_16x16x32_bf16(wf[0][nt][0], af0, ga, 0, 0, 0); ga = __builtin_amdgcn_mfma_f32_16x16x32_bf16(wf[0][nt][1], af1, ga, 0, 0, 0);
                gi = __builtin_amdgcn_mfma_f32_16x16x32_bf16(wf[1][nt][0], af0, gi, 0, 0, 0); gi = __builtin_amdgcn_mfma_f32_16x16x32_bf16(wf[1][nt][1], af1, gi, 0, 0, 0);
                f32x4 av, uv;
#pragma unroll
                for (int e = 0; e < 4; ++e) { const float rec = sigmoidf_(ga[e] + bav[nt][e]), inp = sigmoidf_(gi[e] + biv[nt][e]); const float la = -spv[nt][e] * rec;
                    av[e] = __expf(la); uv[e] = sqrtf(-expm1f(2.0f * la)) * inp; }
                *(LAS f32x4*)(as_ + fr * 36 + 16 * nt + 4 * fq) = av; *(LAS f32x4*)(us + fr * 36 + 16 * nt + 4 * fq) = uv;
            }
            LDS_WAIT();
#pragma unroll
            for (int tt = 0; tt < 16; ++tt) { const int ti = (d == 0) ? tt : 15 - tt; const float a = as_[ti * 36 + c], uu = us[ti * 36 + c] * xs[ti * 36 + c];
                hst = a * hst + uu; Pa *= a;
                if (PASS == 2) { const int row = sb * 16 + ti;
                    if (lane < 32) {
                        if (d == 1) hs[row * 256 + own + c] = (bf16_t)f2bf(hst);
                        else { const float hb = bf2f(hs[row * 256 + own + c]); const float lg = bf2f(Z[(size_t)(tok0 + row) * DINP + ZC_LG + own + c]); hs[row * 256 + own + c] = (bf16_t)f2bf(gelu_tanh(lg) * (hst + hb)); } } } }
            LDS_WAIT();
        }
        if (PASS == 1 && lane < 32) { const size_t o = (size_t)((b * 2 + d) * LRU_NCH + ck) * 256 + own + c; aggA[o] = Pa; aggH[o] = hst; }
    }
    if (PASS == 2) {
        __syncthreads();
#pragma unroll 1
        for (int i = 0; i < 16; ++i) { const int row = wid * 16 + i; const u32x2 w = *(const LAS u32x2*)(hs + row * 256 + 4 * lane);
            const float v0 = bflo(w.x), v1 = bfhi(w.x), v2 = bflo(w.y), v3 = bfhi(w.y);
            const float ss = wave_sum(v0 * v0 + v1 * v1 + v2 * v2 + v3 * v3); const float rs = rsqrtf(ss * (1.0f / 256.0f) + RMS_EPS);
            const f32x4 g = *(const f32x4*)(glru + 4 * lane);
            u32x2 o; o.x = pk2(v0 * rs * g[0], v1 * rs * g[1]); o.y = pk2(v2 * rs * g[2], v3 * rs * g[3]);
            *(u32x2*)(Y + (size_t)(tok0 + row) * DM + 768 + 4 * lane) = o; }
        __syncthreads();
    }
}
}

#define XB_TMO      128
#define XB_XCNT(j)  (256  + 64 * (j))
#define XB_XSUB(j)  (1280 + 64 * (j))
#define XB_XGEN(j)  (2304 + 64 * (j))
#define XB_TOP      3328
#define XB_TOPGEN   3392
#define XCD_BAR_WORDS 3456
#define XB_SPIN_CAP (1u << 18)
__device__ __forceinline__ unsigned xb_ld(unsigned* p)              { return __hip_atomic_load(p, __ATOMIC_RELAXED, __HIP_MEMORY_SCOPE_AGENT); }
__device__ __forceinline__ unsigned xb_add(unsigned* p, unsigned v) { return __hip_atomic_fetch_add(p, v, __ATOMIC_RELAXED, __HIP_MEMORY_SCOPE_AGENT); }
__device__ __forceinline__ unsigned xb_xcc_id() { return (unsigned)__builtin_amdgcn_s_getreg((3 << 11) | 20) & 0xFu; }
#define XB_SPIN(cond, bar) do { unsigned _sp = 0; while (cond) { __builtin_amdgcn_s_sleep(1); \
    if ((++_sp & 255u) == 0u) { if (xb_ld(&(bar)[XB_TMO])) break; if (_sp > XB_SPIN_CAP) { atomicAdd(&(bar)[XB_TMO], 1u); break; } } } } while (0)
struct XcdBarrier { unsigned* bar; unsigned x; volatile LAS unsigned* st; };
__device__ __forceinline__ XcdBarrier xcd_barrier_post(unsigned* bar, volatile LAS unsigned* st) {
    XcdBarrier b; b.bar = bar; b.x = xb_xcc_id(); b.st = st;
    if (threadIdx.x == 0) (void)xb_add(&bar[XB_XCNT(b.x)], 1u);
    return b;
}
__device__ __forceinline__ void xcd_barrier_complete(unsigned* bar, unsigned x, unsigned& nloc, unsigned& nx) {
    const unsigned G = gridDim.x * gridDim.y * gridDim.z;
    unsigned sum, cnt, mine, sp = 0u;
    for (;;) {
        sum = 0u; cnt = 0u; mine = 0u;
#pragma unroll
        for (unsigned j = 0; j < 16; ++j) { const unsigned c = xb_ld(&bar[XB_XCNT(j)]); sum += c; cnt += (c > 0u) ? 1u : 0u; mine = (j == x) ? c : mine; }
        if (sum == G) break;
        __builtin_amdgcn_s_sleep(1);
        if ((++sp & 255u) == 0u) { if (xb_ld(&bar[XB_TMO])) break; if (sp > XB_SPIN_CAP) { atomicAdd(&bar[XB_TMO], 1u); break; } }
    }
    nloc = mine > 0u ? mine : 1u; nx = cnt > 0u ? cnt : 1u;
}
__device__ __forceinline__ void xcd_barrier(const XcdBarrier& b) {
    asm volatile("s_waitcnt vmcnt(0)" ::: "memory");
    __syncthreads();
    if (threadIdx.x == 0) {
        unsigned* bar = b.bar;
        __builtin_amdgcn_s_waitcnt(0);
        unsigned nloc = b.st[0], nx = b.st[1];
        if (nloc == 0u) { xcd_barrier_complete(bar, b.x, nloc, nx); b.st[0] = nloc; b.st[1] = nx; }
        const unsigned old = xb_add(&bar[XB_XSUB(b.x)], 1u);
        const unsigned gen = old / nloc;
        if (old + 1u == (gen + 1u) * nloc) {
            __builtin_amdgcn_fence(__ATOMIC_RELEASE, "agent");
            asm volatile("s_waitcnt vmcnt(0)" ::: "memory");
            const unsigned og = xb_add(&bar[XB_TOP], 1u);
            const unsigned tg = og / nx;
            if (og + 1u == (tg + 1u) * nx) xb_add(&bar[XB_TOPGEN], 1u);
            else XB_SPIN(xb_ld(&bar[XB_TOPGEN]) == tg, bar);
            __builtin_amdgcn_fence(__ATOMIC_ACQUIRE, "agent");
            xb_add(&bar[XB_XGEN(b.x)], 1u);
            asm volatile("s_waitcnt vmcnt(0)" ::: "memory");
        } else {
            XB_SPIN(xb_ld(&bar[XB_XGEN(b.x)]) == gen, bar);
            __builtin_amdgcn_fence(__ATOMIC_ACQUIRE, "agent");
            asm volatile("s_waitcnt vmcnt(0)" ::: "memory");
        }
    }
    __syncthreads();
}

struct Args { const float* in[29]; float* out; unsigned char* ws; int ph_lo, ph_hi; };
enum { I_X = 0, I_LNG, I_LNB, I_WIN, I_CONVW, I_QNG, I_WUQ, I_KVNG, I_WUKV, I_LCW, I_LCB, I_LWA, I_LBA, I_LWI, I_LBI, I_LAM, I_MIXG, I_WOUT, I_LN1G, I_LN1B,
       I_DWG, I_DWU, I_DWD, I_RTR, I_MWG, I_MWU, I_MWD, I_LN2G, I_LN2B };
struct Ctx { LAS unsigned char* lds; int tid, lane, wave, G, blk, gw, ngw; };
typedef const __attribute__((address_space(4))) Args* ArgsP;
__device__ __forceinline__ unsigned char* wsp(ArgsP a) { unsigned long long v = (unsigned long long)a->ws; asm volatile("" : "+s"(v)); return (unsigned char*)v; }
__device__ __forceinline__ ArgsP args_ptr() { unsigned long long v = (unsigned long long)__builtin_amdgcn_kernarg_segment_ptr(); asm volatile("" : "+s"(v)); return (ArgsP)v; }

struct RmId { __device__ __forceinline__ int operator()(int n) const { return n; } };
struct RmGU { int up; __device__ __forceinline__ int operator()(int n) const { return 256 * (n >> 7) + 128 * up + (n & 127); } };
struct RmKV { int v; __device__ __forceinline__ int operator()(int n) const { return (n >> 7) * 64 + (n & 63); } };
template <class RM>
__device__ __forceinline__ void transpose_item(const float* W, int N, bf16_t* WT, int ldo, const float* kscale, LAS float* scr, int kb, int nb, int lane, RM rm, float kmul = 1.0f) {
    const int k0 = 64 * kb, n0 = 32 * nb;
#pragma unroll 8
    for (int i = 0; i < 32; ++i) { const int kk = 2 * i + (lane >> 5); scr[kk * 33 + (lane & 31)] = W[(size_t)(k0 + kk) * N + n0 + (lane & 31)]; }
    LDS_WAIT(); asm volatile("" ::: "memory");
    const int c = lane & 7;
    float ks[8];
#pragma unroll
    for (int e = 0; e < 8; ++e) ks[e] = (kscale ? kscale[k0 + 8 * c + e] : 1.0f) * kmul;
#pragma unroll
    for (int j = 0; j < 4; ++j) { const int n = (lane >> 3) + 8 * j; const LAS float* s = scr + (8 * c) * 33 + n;
        u32x4 o; o.x = pk2(s[0 * 33] * ks[0], s[1 * 33] * ks[1]); o.y = pk2(s[2 * 33] * ks[2], s[3 * 33] * ks[3]); o.z = pk2(s[4 * 33] * ks[4], s[5 * 33] * ks[5]); o.w = pk2(s[6 * 33] * ks[6], s[7 * 33] * ks[7]);
        *(u32x4*)(WT + (size_t)rm(n0 + n) * ldo + k0 + 8 * c) = o; }
    LDS_WAIT(); asm volatile("" ::: "memory");
}
template <class RM>
__device__ __forceinline__ void transpose_matrix(const Ctx& C, int& it0, const float* W, int K, int N, bf16_t* WT, int ldo, const float* kscale, RM rm, float kmul = 1.0f) {
    LAS float* scr = (LAS float*)(C.lds + C.wave * 16384);
    const int nkb = K / 64, nnb = N / 32, total = nkb * nnb;
    int first = (C.gw - (it0 % C.ngw) + C.ngw) % C.ngw;
    for (int it = first; it < total; it += C.ngw) transpose_item(W, N, WT, ldo, kscale, scr, it / nnb, it % nnb, C.lane, rm, kmul);
    it0 += total;
}
__device__ __forceinline__ void ln_row(const float* src, const float* g, const float* bta, float* dstf, bf16_t* dstb, int lane, f32x4 (&v)[4]) {
    float s = 0.f;
#pragma unroll
    for (int j = 0; j < 4; ++j) { v[j] = *(const f32x4*)(src + 4 * lane + 256 * j); s += (v[j][0] + v[j][1]) + (v[j][2] + v[j][3]); }
    const float mean = wave_sum(s) * (1.0f / DM); float s2 = 0.f;
#pragma unroll
    for (int j = 0; j < 4; ++j) { v[j] = v[j] - mean; s2 += (v[j][0] * v[j][0] + v[j][1] * v[j][1]) + (v[j][2] * v[j][2] + v[j][3] * v[j][3]); }
    const float rstd = rsqrtf(wave_sum(s2) * (1.0f / DM) + LN_EPS);
#pragma unroll
    for (int j = 0; j < 4; ++j) { const f32x4 gg = *(const f32x4*)(g + 4 * lane + 256 * j), bb = *(const f32x4*)(bta + 4 * lane + 256 * j);
        v[j] = v[j] * rstd * gg + bb; *(f32x4*)(dstf + 4 * lane + 256 * j) = v[j];
        u32x2 w; w.x = pk2(v[j][0], v[j][1]); w.y = pk2(v[j][2], v[j][3]); *(u32x2*)(dstb + 4 * lane + 256 * j) = w; }
}

__device__ __forceinline__ void phase_prologue(const Ctx& C, ArgsP a) {
    unsigned char* ws = wsp(a); int it0 = 0;
    for (int l = 0; l < 2; ++l) {
        transpose_matrix(C, it0, a->in[I_WIN] + (size_t)l * DM * DIN, DM, DIN, (bf16_t*)(ws + WS_WIN) + (size_t)l * DINP * DM, DM, nullptr, RmId{});
        transpose_matrix(C, it0, a->in[I_WUQ] + (size_t)l * QRANK * QW, QRANK, QW, (bf16_t*)(ws + WS_WUQ) + (size_t)l * QW * QRANK, QRANK, a->in[I_QNG] + l * QRANK, RmId{}, QSCALE);
        transpose_matrix(C, it0, a->in[I_WOUT] + (size_t)l * DM * DM, DM, DM, (bf16_t*)(ws + WS_WOUT) + (size_t)l * DM * DM, DM, nullptr, RmId{});
        { LAS float* scr = (LAS float*)(C.lds + C.wave * 16384); const float* W = a->in[I_WUKV] + (size_t)l * KVRANK * 1024; const int total = 4 * 32;
          int first = (C.gw - (it0 % C.ngw) + C.ngw) % C.ngw;
          for (int it = first; it < total; it += C.ngw) { const int kb = it / 32, nb = it % 32; const bool isv = (nb & 3) >= 2;
              transpose_item(W, 1024, (bf16_t*)(ws + (isv ? WS_WV : WS_WK)) + (size_t)l * 512 * KVRANK, KVRANK, a->in[I_KVNG] + l * KVRANK, scr, kb, nb, C.lane, RmKV{0}); }
          it0 += total; }
        for (int d = 0; d < 2; ++d) for (int g = 0; g < 2; ++g) for (int n = 0; n < 4; ++n)
            transpose_matrix(C, it0, a->in[g == 0 ? I_LWA : I_LWI] + (size_t)(((l * 2 + d) * 4 + n) * 4096), 64, 64, (bf16_t*)(ws + WS_LRUW) + (size_t)((((l * 2 + d) * 2 + g) * 4 + n) * 4096), 64, nullptr, RmId{});
    }
    transpose_matrix(C, it0, a->in[I_DWG], DM, DFF, (bf16_t*)(ws + WS_WGU), DM, nullptr, RmGU{0});
    transpose_matrix(C, it0, a->in[I_DWU], DM, DFF, (bf16_t*)(ws + WS_WGU), DM, nullptr, RmGU{1});
    transpose_matrix(C, it0, a->in[I_DWD], DFF, DM, (bf16_t*)(ws + WS_WD), DFF, nullptr, RmId{});
    const int gt = C.blk * 512 + C.tid, ngt = C.G * 512;
    for (int i = gt; i < 2 * 96 * DM / 8; i += ngt) { const int l = i / (96 * DM / 8), r = i % (96 * DM / 8); *(u32x4*)((bf16_t*)(ws + WS_WIN) + (size_t)l * DINP * DM + (size_t)DIN * DM + (size_t)r * 8) = (u32x4){0u, 0u, 0u, 0u}; }
    for (int i = gt; i < 1024; i += ngt) { const float lam = a->in[I_LAM][i]; ((float*)(ws + WS_C8SP))[i] = 8.0f * (fmaxf(-lam, 0.f) + log1pf(expf(-fabsf(lam)))); }
    for (int i = gt; i < SEQ * 16; i += ngt) { const int pos = i >> 4, k = i & 15; const double inv = exp(-9.210340371976184 * (double)k / 16.0); const double ang = (double)pos * inv;
        ((f32x2*)(ws + WS_ROPE))[i] = (f32x2){(float)cos(ang), (float)sin(ang)}; }
    for (int row = C.gw; row < NTOK; row += C.ngw) { f32x4 v[4]; ln_row(a->in[I_X] + (size_t)row * DM, a->in[I_LNG], a->in[I_LNB], a->out + (size_t)row * DM, (bf16_t*)(ws + WS_XB) + (size_t)row * DM, C.lane, v); }
}

__device__ __forceinline__ void phase_tokenlocal(const Ctx& C, ArgsP a, int l) {
    unsigned char* ws = wsp(a); const bf16_t* Z = (const bf16_t*)(ws + WS_Z); bf16_t* Y = (bf16_t*)(ws + WS_Y); bf16_t* KR = (bf16_t*)(ws + WS_KR);
    bf16_t* CQN = (bf16_t*)(ws + WS_CQN); bf16_t* CKVN = (bf16_t*)(ws + WS_CKVN); const f32x2* rope = (const f32x2*)(ws + WS_ROPE);
    const int lane = C.lane;
    const float* cwp = a->in[I_CONVW] + (size_t)l * 3 * 256; const f32x4 w0 = *(const f32x4*)(cwp + 4 * lane), w1 = *(const f32x4*)(cwp + 256 + 4 * lane), w2 = *(const f32x4*)(cwp + 512 + 4 * lane);
    const f32x4 gc = *(const f32x4*)(a->in[I_MIXG] + (size_t)l * DM + 4 * lane);
    for (int row = C.gw; row < NTOK; row += C.ngw) {
        const bf16_t* zr = Z + (size_t)row * DINP; const int pos = row & (SEQ - 1);
        float sq = 0.f; float qx[6];
#pragma unroll
        for (int j = 0; j < 3; ++j) { const unsigned w = *(const unsigned*)(zr + ZC_Q + 2 * lane + 128 * j); qx[2 * j] = bflo(w); qx[2 * j + 1] = bfhi(w); sq += qx[2 * j] * qx[2 * j] + qx[2 * j + 1] * qx[2 * j + 1]; }
        const u32x2 wk = *(const u32x2*)(zr + ZC_KV + 4 * lane); const float k0 = bflo(wk.x), k1 = bfhi(wk.x), k2 = bflo(wk.y), k3 = bfhi(wk.y);
        const float skv = wave_sum(k0 * k0 + k1 * k1 + k2 * k2 + k3 * k3); sq = wave_sum(sq);
        { const float rq = rsqrtf(sq * (1.0f / QRANK) + RMS_EPS), rk = rsqrtf(skv * (1.0f / KVRANK) + RMS_EPS);
#pragma unroll
          for (int j = 0; j < 3; ++j) *(unsigned*)(CQN + (size_t)row * QRANK + 2 * lane + 128 * j) = pk2(qx[2 * j] * rq, qx[2 * j + 1] * rq);
          u32x2 o; o.x = pk2(k0 * rk, k1 * rk); o.y = pk2(k2 * rk, k3 * rk); *(u32x2*)(CKVN + (size_t)row * KVRANK + 4 * lane) = o; }
        if (lane < 16) { const float x1 = bf2f(zr[ZC_KR + lane]), x2 = bf2f(zr[ZC_KR + 16 + lane]); const f32x2 cs = rope[(size_t)pos * 16 + lane];
            KR[(size_t)row * 32 + lane] = (bf16_t)f2bf(x1 * cs[0] - x2 * cs[1]); KR[(size_t)row * 32 + 16 + lane] = (bf16_t)f2bf(x2 * cs[0] + x1 * cs[1]); }
        f32x4 acc = (f32x4){0.f, 0.f, 0.f, 0.f};
#pragma unroll
        for (int k = 0; k < 3; ++k) { const int p2 = pos + k - 1;
            if (p2 >= 0 && p2 < SEQ) { const bf16_t* zz = zr + (ptrdiff_t)(k - 1) * DINP; const u32x2 cw_ = *(const u32x2*)(zz + ZC_C + 4 * lane), hw = *(const u32x2*)(zz + ZC_H + 4 * lane);
                const f32x4 ch = (f32x4){bflo(cw_.x) * bflo(hw.x), bfhi(cw_.x) * bfhi(hw.x), bflo(cw_.y) * bflo(hw.y), bfhi(cw_.y) * bfhi(hw.y)};
                acc += (k == 0 ? w0 : (k == 1 ? w1 : w2)) * ch; } }
        const u32x2 bw = *(const u32x2*)(zr + ZC_B + 4 * lane);
        acc = acc * (f32x4){bflo(bw.x), bfhi(bw.x), bflo(bw.y), bfhi(bw.y)};
        const float ss = wave_sum(acc[0] * acc[0] + acc[1] * acc[1] + acc[2] * acc[2] + acc[3] * acc[3]); const float rs = rsqrtf(ss * (1.0f / 256.0f) + RMS_EPS);
        u32x2 o; o.x = pk2(acc[0] * rs * gc[0], acc[1] * rs * gc[1]); o.y = pk2(acc[2] * rs * gc[2], acc[3] * rs * gc[3]);
        *(u32x2*)(Y + (size_t)row * DM + 4 * lane) = o;
    }
    for (int u = C.blk; u < NBATCH * LRU_NCH; u += C.G)
        lru::lru_unit<1>(u / LRU_NCH, u % LRU_NCH, l, Z, (const bf16_t*)(ws + WS_LRUW), (const float*)(ws + WS_C8SP), a->in[I_LCW], a->in[I_LCB], a->in[I_LBA], a->in[I_LBI],
                         (float*)(ws + WS_AGGA), (float*)(ws + WS_AGGH), a->in[I_MIXG] + (size_t)l * DM + 768, Y, C.lds);
}

__device__ __forceinline__ void phase_mlanorm(const Ctx& C, ArgsP a, int l) {
    bf16_t* Y = (bf16_t*)(a->ws + WS_Y); const int lane = C.lane; const float* g = a->in[I_MIXG] + (size_t)l * DM + 256 + 8 * lane;
    const f32x4 g0 = *(const f32x4*)g, g1 = *(const f32x4*)(g + 4);
    for (int row = C.gw; row < NTOK; row += C.ngw) { u32x4* p = (u32x4*)(Y + (size_t)row * DM + 256 + 8 * lane); const u32x4 w = *p;
        float v[8] = {bflo(w.x), bfhi(w.x), bflo(w.y), bfhi(w.y), bflo(w.z), bfhi(w.z), bflo(w.w), bfhi(w.w)}; float s = 0.f;
#pragma unroll
        for (int e = 0; e < 8; ++e) s += v[e] * v[e];
        const float rs = rsqrtf(wave_sum(s) * (1.0f / 512.0f) + RMS_EPS);
        u32x4 o; o.x = pk2(v[0] * rs * g0[0], v[1] * rs * g0[1]); o.y = pk2(v[2] * rs * g0[2], v[3] * rs * g0[3]); o.z = pk2(v[4] * rs * g1[0], v[5] * rs * g1[1]); o.w = pk2(v[6] * rs * g1[2], v[7] * rs * g1[3]);
        *p = o; }
}

template <bool ROUTE>
__device__ __forceinline__ void phase_ln(const Ctx& C, ArgsP a, const float* g, const float* bta) {
    unsigned char* ws = wsp(a); float* X = a->out; bf16_t* XB = (bf16_t*)(ws + WS_XB);
    LAS float* wr_ = (LAS float*)C.lds;
    LAS unsigned* hist = (LAS unsigned*)(C.lds + 32768);
    unsigned* cnt = (unsigned*)(ws + WS_CTL) + CW_CNT;
    int* tok_e = (int*)(ws + WS_TOKE); int* tok_r = (int*)(ws + WS_TOKR); float* tok_g = (float*)(ws + WS_TOKG);
    if (ROUTE) {
        for (int i = C.tid; i < DM * NEXP / 4; i += 512) ((LAS f32x4*)wr_)[i] = ((const f32x4*)a->in[I_RTR])[i];
        if (C.tid < 32) hist[C.tid] = 0u;
        __syncthreads();
    }
    for (int row = C.gw; row < NTOK; row += C.ngw) {
        f32x4 v[4]; ln_row(X + (size_t)row * DM, g, bta, X + (size_t)row * DM, XB + (size_t)row * DM, C.lane, v);
        if (ROUTE) {
            float lg[8];
#pragma unroll
            for (int e = 0; e < 8; ++e) lg[e] = 0.f;
#pragma unroll
            for (int j = 0; j < 4; ++j)
#pragma unroll
                for (int q = 0; q < 4; ++q) { const int c = 4 * C.lane + 256 * j + q; const f32x4 wa = *(const LAS f32x4*)(wr_ + c * 8), wb = *(const LAS f32x4*)(wr_ + c * 8 + 4); const float x = v[j][q];
                    lg[0] += x * wa[0]; lg[1] += x * wa[1]; lg[2] += x * wa[2]; lg[3] += x * wa[3]; lg[4] += x * wb[0]; lg[5] += x * wb[1]; lg[6] += x * wb[2]; lg[7] += x * wb[3]; }
#pragma unroll
            for (int e = 0; e < 8; ++e) lg[e] = wave_sum(lg[e]);
            int e0 = 0; float v0 = lg[0];
#pragma unroll
            for (int e = 1; e < 8; ++e) if (lg[e] > v0) { v0 = lg[e]; e0 = e; }
            int e1 = -1; float v1 = -INFINITY;
#pragma unroll
            for (int e = 0; e < 8; ++e) if (e != e0 && lg[e] > v1) { v1 = lg[e]; e1 = e; }
            const float g0 = 1.0f / (1.0f + expf(v1 - v0)), g1 = 1.0f - g0;
            if (C.lane == 0) { const unsigned r0 = atomicAdd((unsigned*)&hist[e0], 1u), r1 = atomicAdd((unsigned*)&hist[8 + e1], 1u);
                tok_e[row] = e0; tok_e[NTOK + row] = e1; tok_r[row] = (int)r0; tok_r[NTOK + row] = (int)r1; tok_g[row] = g0; tok_g[NTOK + row] = g1; }
        }
    }
    if (ROUTE) {
        VM_WAIT(); __syncthreads();
        if (C.tid < 16) hist[16 + C.tid] = atomicAdd(&cnt[C.tid], hist[C.tid]);
        __syncthreads();
        int* list = (int*)(ws + WS_LIST); float* glist = (float*)(ws + WS_GLIST);
        for (int row = C.gw; row < NTOK; row += C.ngw) {
            if (C.lane < 2) { const int p = C.lane; const int e = tok_e[p * NTOK + row]; const int slot = (int)hist[16 + p * 8 + e] + tok_r[p * NTOK + row];
                list[(size_t)(p * 8 + e) * NTOK + slot] = row; glist[(size_t)(p * 8 + e) * NTOK + slot] = tok_g[p * NTOK + row]; } }
        __syncthreads();
        int it0 = 0;
        for (int e = 0; e < NEXP; ++e) {
            transpose_matrix(C, it0, a->in[I_MWG] + (size_t)e * DM * DFF, DM, DFF, (bf16_t*)(ws + WS_WGUM) + (size_t)e * 2 * DFF * DM, DM, nullptr, RmGU{0});
            transpose_matrix(C, it0, a->in[I_MWU] + (size_t)e * DM * DFF, DM, DFF, (bf16_t*)(ws + WS_WGUM) + (size_t)e * 2 * DFF * DM, DM, nullptr, RmGU{1});
            transpose_matrix(C, it0, a->in[I_MWD] + (size_t)e * DFF * DM, DFF, DM, (bf16_t*)(ws + WS_WDM) + (size_t)e * DM * DFF, DFF, nullptr, RmId{});
        }
    }
}

constexpr int NPH_LAYER = 12, NPHASES = 1 + 2 * NPH_LAYER;
template <int KSEL>
__global__ void __launch_bounds__(512, 2) fwd_kernel(Args a_) {
    extern __shared__ __attribute__((aligned(16))) unsigned char lds_raw[];
    Ctx C0; C0.lds = (LAS unsigned char*)lds_raw; C0.tid = threadIdx.x; C0.lane = C0.tid & 63; C0.wave = __builtin_amdgcn_readfirstlane(C0.tid >> 6);
    C0.G = gridDim.x; C0.blk = blockIdx.x; C0.gw = C0.blk * 8 + C0.wave; C0.ngw = C0.G * 8;
    unsigned char* ws0 = a_.ws;
    volatile LAS unsigned* MISC = (volatile LAS unsigned*)(C0.lds + MISC_OFF);
    if (C0.tid < 64) MISC[C0.tid] = 0u;
    __syncthreads();
    XcdBarrier bar; bar.bar = (unsigned*)(ws0 + WS_CTL) + CW_BAR; bar.x = 0; bar.st = MISC + 8;
    const int lo = a_.ph_lo, hi = a_.ph_hi;
    const bool multi = (KSEL < 0) && (hi - lo) > 1;
    if (multi) bar = xcd_barrier_post((unsigned*)(ws0 + WS_CTL) + CW_BAR, MISC + 8);
#define IN(k) (KSEL < 0 ? (lo <= (k) && (k) < hi) : (KSEL == 100 ? (k) == 0 : ((k) > 0 && KSEL == ((k) - 1) % NPH_LAYER && (k) == lo)))
#define SITE Ctx C = C0; { int t_ = threadIdx.x; asm volatile("" : "+v"(t_)); C.tid = t_; C.lane = t_ & 63; } ArgsP a = args_ptr(); unsigned char* ws = wsp(a); const bf16_t* XB = (const bf16_t*)(ws + WS_XB); bf16_t* Z = (bf16_t*)(ws + WS_Z); bf16_t* Y = (bf16_t*)(ws + WS_Y); (void)XB; (void)Z; (void)Y; (void)a
#define MOEP const unsigned* cnt = (const unsigned*)(ws + WS_CTL) + CW_CNT; const int* list = (const int*)(ws + WS_LIST); const float* glist = (const float*)(ws + WS_GLIST); (void)glist
#define REP(j) for (int rep_ = 0; rep_ < (((PROBE_REPEAT >> (j)) & 1) ? 2 : 1); ++rep_)
#define INJ(j) (KSEL < 0 ? (lo <= pb + (j) && pb + (j) < hi) : (KSEL == (j) && lo == pb + (j)))
#define SEAM(k) do { if (KSEL < 0) { if (multi && (k) + 1 < hi) xcd_barrier(bar); } } while (0)
    if (IN(0)) { Ctx C = C0; { int t_ = threadIdx.x; asm volatile("" : "+v"(t_)); C.tid = t_; C.lane = t_ & 63; } ArgsP a = args_ptr(); phase_prologue(C, a); SEAM(0); }
#pragma unroll 1
    for (int l = 0; l < 2; ++l) {
        const int pb = 1 + NPH_LAYER * l;
        if (INJ(0)) REP(0) { SITE;
            pg8::Gemm g{XB, (const bf16_t*)(ws + WS_WIN) + (size_t)l * DINP * DM, DM, DM, DM}; pg8::StaticOrder S; S.init(NTOK, DINP, C.G, C.blk, DM, DM);
            EpiStore E{Z, DINP, nullptr};
            pg8::gemm_phase<EpiStore, pg8::StaticOrder, true, false>(C.lds, g, S, E);
            SEAM(pb + 0);
        }
        if (INJ(1)) REP(1) { SITE; phase_tokenlocal(C, a, l); SEAM(pb + 1); }
        if (INJ(2)) REP(2) { SITE;
#if !defined(UPSEL) || UPSEL == 1
            { pg8::Gemm g{(const bf16_t*)(ws + WS_CQN), (const bf16_t*)(ws + WS_WUQ) + (size_t)l * QW * QRANK, QRANK, QRANK, QRANK}; pg8::StaticOrder S; S.init(NTOK, QW, C.G, C.blk, QRANK, QRANK);
              EpiQ E{(bf16_t*)(ws + WS_Q), (const f32x2*)(ws + WS_ROPE)};
              pg8::gemm_phase<EpiQ, pg8::StaticOrder, true, false>(C.lds, g, S, E); }
#endif
#if !defined(UPSEL) || UPSEL == 2
            { pg8::Gemm g{(const bf16_t*)(ws + WS_CKVN), (const bf16_t*)(ws + WS_WK) + (size_t)l * 512 * KVRANK, KVRANK, KVRANK, KVRANK}; pg8::StaticOrder S; S.init(NTOK, 512, C.G, C.blk, KVRANK, KVRANK);
              EpiStore E{(bf16_t*)(ws + WS_KN), 512, nullptr};
              pg8::gemm_phase<EpiStore, pg8::StaticOrder, true, false>(C.lds, g, S, E); }
#endif
#if !defined(UPSEL) || UPSEL == 3
            { pg8::Gemm g{(const bf16_t*)(ws + WS_WV) + (size_t)l * 512 * KVRANK, (const bf16_t*)(ws + WS_CKVN), KVRANK, KVRANK, KVRANK}; pg8::StaticOrder S; S.init(512, NTOK, C.G, C.blk, KVRANK, KVRANK);
              EpiVT E{(bf16_t*)(ws + WS_VT)};
              pg8::gemm_phase<EpiVT, pg8::StaticOrder, true, false>(C.lds, g, S, E); }
#endif
            SEAM(pb + 2);
        }
        if (INJ(3)) REP(3) { SITE;
            for (int u = C.blk; u < NBATCH * LRU_NCH; u += C.G)
                lru::lru_unit<2>(u / LRU_NCH, u % LRU_NCH, l, Z, (const bf16_t*)(ws + WS_LRUW), (const float*)(ws + WS_C8SP), a->in[I_LCW], a->in[I_LCB], a->in[I_LBA], a->in[I_LBI],
                                 (float*)(ws + WS_AGGA), (float*)(ws + WS_AGGH), a->in[I_MIXG] + (size_t)l * DM + 768, Y, C.lds);
            const int nun = NBATCH * 8 * (SEQ / 256);
            for (int i = 0; ; ++i) {
                int bh, qb;
                if (C.G == 256) { if (i >= 4) break; bh = i * 8 + (C.blk & 7); qb = C.blk >> 3; }
                else { const int L = i * C.G + C.blk; if (L >= nun) break; bh = L >> 5; qb = L & 31; }
                att::attn_unit(bh >> 3, bh & 7, qb, (const bf16_t*)(ws + WS_Q), (const bf16_t*)(ws + WS_KN), (const bf16_t*)(ws + WS_KR), (const bf16_t*)(ws + WS_VT), Y, C.lds);
            }
            SEAM(pb + 3);
        }
        if (INJ(4)) { SITE; phase_mlanorm(C, a, l); SEAM(pb + 4); }
        if (INJ(5)) { SITE;
            pg8::Gemm g{Y, (const bf16_t*)(ws + WS_WOUT) + (size_t)l * DM * DM, DM, DM, DM}; pg8::StaticOrder S; S.init(NTOK, DM, C.G, C.blk, DM, DM);
            EpiResid E{a->out};
            pg8::gemm_phase<EpiResid, pg8::StaticOrder, true, false>(C.lds, g, S, E);
            SEAM(pb + 5);
        }
        if (INJ(6)) { SITE;
            if (l == 0) phase_ln<false>(C, a, a->in[I_LN1G] + (size_t)l * DM, a->in[I_LN1B] + (size_t)l * DM);
            else phase_ln<true>(C, a, a->in[I_LN1G] + (size_t)l * DM, a->in[I_LN1B] + (size_t)l * DM);
            SEAM(pb + 6);
        }
        if (l == 0) {
            if (INJ(7)) REP(7) { SITE;
                pg8::Gemm g{XB, (const bf16_t*)(ws + WS_WGU), DM, DM, DM}; pg8::StaticOrder S; S.init(NTOK, 2 * DFF, C.G, C.blk, DM, DM);
                EpiSwiglu E{(bf16_t*)(ws + WS_H)};
                pg8::gemm_phase<EpiSwiglu, pg8::StaticOrder, true, false>(C.lds, g, S, E);
                SEAM(pb + 7);
            }
            if (INJ(8)) { SITE;
                pg8::Gemm g{(const bf16_t*)(ws + WS_H), (const bf16_t*)(ws + WS_WD), DFF, DFF, DFF}; pg8::StaticOrder S; S.init(NTOK, DM, C.G, C.blk, DFF, DFF);
                EpiResid E{a->out};
                pg8::gemm_phase<EpiResid, pg8::StaticOrder, true, false>(C.lds, g, S, E);
                SEAM(pb + 8);
            }
        } else {
#pragma unroll
            for (int p = 0; p < 2; ++p) {
                if (INJ(7 + 2 * p)) REP(7) { SITE; MOEP;
                    pg8::Gemm g{XB, (const bf16_t*)(ws + WS_WGUM), DM, DM, DM}; pg8::MoeOrder S; S.init(cnt, p, 2 * DFF / 256, C.G, C.blk, list, 0, DM, DM, (size_t)2 * DFF * DM * 2);
                    EpiSwiglu E{(bf16_t*)(ws + WS_HM)};
                    pg8::gemm_phase<EpiSwiglu, pg8::MoeOrder, true, true>(C.lds, g, S, E);
                    SEAM(pb + 7 + 2 * p);
                }
                if (INJ(8 + 2 * p)) { SITE; MOEP;
                    pg8::Gemm g{(const bf16_t*)(ws + WS_HM), (const bf16_t*)(ws + WS_WDM), DFF, DFF, DFF}; pg8::MoeOrder S; S.init(cnt, p, DM / 256, C.G, C.blk, list, 1, DFF, DFF, (size_t)DM * DFF * 2);
                    EpiMoeDown E{a->out, list, glist, p};
                    pg8::gemm_phase<EpiMoeDown, pg8::MoeOrder, true, false>(C.lds, g, S, E);
                    SEAM(pb + 8 + 2 * p);
                }
            }
        }
        if (INJ(11)) { SITE; phase_ln<false>(C, a, a->in[I_LN2G] + (size_t)l * DM, a->in[I_LN2B] + (size_t)l * DM); SEAM(pb + 11); }
    }
#undef IN
#undef INJ
#undef SITE
#undef REP
#undef MOEP
#undef SEAM
}

#if MEGA
constexpr int NKERN = 1;
static const void* kern_tab(int) { return (const void*)fwd_kernel<-1>; }
#else
constexpr int NKERN = 13;
static const void* kern_tab(int k) {
    switch (k) { case 0: return (const void*)fwd_kernel<0>; case 1: return (const void*)fwd_kernel<1>; case 2: return (const void*)fwd_kernel<2>; case 3: return (const void*)fwd_kernel<3>;
        case 4: return (const void*)fwd_kernel<4>; case 5: return (const void*)fwd_kernel<5>; case 6: return (const void*)fwd_kernel<6>; case 7: return (const void*)fwd_kernel<7>;
        case 8: return (const void*)fwd_kernel<8>; case 9: return (const void*)fwd_kernel<9>; case 10: return (const void*)fwd_kernel<10>; case 11: return (const void*)fwd_kernel<11>;
        default: return (const void*)fwd_kernel<100>; }
}
#endif
extern "C" void kernel_launch(void* const* d_in, const int* in_sizes, int n_in, void* d_out, int out_size, void* d_ws, size_t ws_size, hipStream_t stream) {
    static int grid = 0;
    if (grid == 0) {
        if (n_in != 29 || in_sizes[0] != NTOK * DM || out_size != NTOK * DM || ws_size < WS_END) { fprintf(stderr, "kernel_launch: unexpected shapes / workspace (%d inputs, ws %zu < %zu)\n", n_in, ws_size, (size_t)WS_END); grid = -1; return; }
        int dev = 0, cus = 0, per_cu = 0;
        if (hipGetDevice(&dev) != hipSuccess || hipDeviceGetAttribute(&cus, hipDeviceAttributeMultiprocessorCount, dev) != hipSuccess) { grid = -1; return; }
        for (int k = 0; k < NKERN; ++k) if (hipFuncSetAttribute(kern_tab(k), hipFuncAttributeMaxDynamicSharedMemorySize, LDS_BYTES) != hipSuccess) { fprintf(stderr, "kernel_launch: hipFuncSetAttribute failed\n"); grid = -1; return; }
        if (hipOccupancyMaxActiveBlocksPerMultiprocessor(&per_cu, kern_tab(0), 512, LDS_BYTES) != hipSuccess || per_cu < 1) { fprintf(stderr, "kernel_launch: occupancy query says %d\n", per_cu); }
        (void)hipGetLastError();
        grid = cus;
    }
    if (grid < 0) return;
    (void)hipMemsetAsync((char*)d_ws + WS_CTL, 0, CTL_ZERO_BYTES, stream);
    Args a{};
    for (int i = 0; i < 29; ++i) a.in[i] = (const float*)d_in[i];
    a.out = (float*)d_out; a.ws = (unsigned char*)d_ws;
#if MEGA
    a.ph_lo = 0; a.ph_hi = NPHASES;
    hipLaunchKernelGGL(fwd_kernel<-1>, dim3(grid), dim3(512), LDS_BYTES, stream, a);
#else
    for (int ph = 0; ph < NPHASES; ++ph) {
        if (ph == 1 + 9 || ph == 1 + 10) continue;
        a.ph_lo = ph; a.ph_hi = ph + 1;
        void* args[] = {&a};
        (void)hipLaunchKernel(kern_tab(ph == 0 ? 12 : (ph - 1) % NPH_LAYER), dim3(grid), dim3(512), args, LDS_BYTES, stream);
    }
#endif
}
```

```cpp
#include <hip/hip_runtime.h>
#include <cstdio>
#include <cstdint>
#include <cmath>

#define LAS __attribute__((address_space(3)))
#define GAS __attribute__((address_space(1)))
typedef unsigned short bf16_t;
typedef short bf16x8 __attribute__((ext_vector_type(8)));
typedef float f32x4 __attribute__((ext_vector_type(4)));
typedef float f32x2 __attribute__((ext_vector_type(2)));
typedef float f32x16 __attribute__((ext_vector_type(16)));
typedef unsigned u32x4 __attribute__((ext_vector_type(4)));
typedef unsigned u32x2 __attribute__((ext_vector_type(2)));

#ifndef PROBE_REPEAT
#define PROBE_REPEAT 0
#endif
#ifndef ATT_SCHED
#define ATT_SCHED 0
#endif
#ifndef MEGA
#define MEGA 1
#endif

constexpr int NTOK = 32768, SEQ = 8192, NBATCH = 4, DM = 1024, DIN = 1952, DINP = 2048, DFF = 3584, NEXP = 8;
constexpr int ZC_B = 0, ZC_C = 256, ZC_H = 512, ZC_Q = 768, ZC_KV = 1152, ZC_KR = 1408, ZC_LG = 1440, ZC_LX = 1696;
constexpr int QW = 768, QRANK = 384, KVRANK = 256;
constexpr float DN_ALPHA = 1.41421356237309515f;
constexpr float LN_EPS = 1e-5f, RMS_EPS = 1e-6f;
constexpr float QSCALE = 0.10206207261596575f * 1.4426950408889634f;
constexpr int LRU_CH = 128, LRU_NCH = SEQ / LRU_CH;

constexpr size_t MiB = 1u << 20;
constexpr size_t WS_CTL = 0, CTL_ZERO_BYTES = 65536;
constexpr size_t WS_ROPE = 1 * MiB;
constexpr size_t WS_RSQ = 2 * MiB, WS_RSKV = 2 * MiB + 131072;
constexpr size_t WS_AGGA = 3 * MiB, WS_AGGH = 3 * MiB + 524288;
constexpr size_t WS_TOKE = 4 * MiB, WS_TOKR = 4 * MiB + 262144, WS_TOKG = 4 * MiB + 524288;
constexpr size_t WS_LIST = 5 * MiB, WS_GLIST = 7 * MiB;
constexpr size_t WS_LRUW = 9 * MiB, WS_C8SP = 9 * MiB + 262144;
constexpr size_t WS_WIN = 10 * MiB, WS_WUQ = 18 * MiB, WS_WK = 20 * MiB, WS_WV = 20 * MiB + 524288, WS_WOUT = 21 * MiB, WS_WGU = 25 * MiB, WS_WD = 39 * MiB;
constexpr size_t WS_XB = 46 * MiB;
constexpr size_t WS_R = 110 * MiB;
constexpr size_t WS_Z = WS_R, WS_Q = WS_R + 128 * MiB, WS_KN = WS_R + 176 * MiB, WS_KR = WS_R + 208 * MiB, WS_VT = WS_R + 210 * MiB, WS_Y = WS_R + 242 * MiB;
constexpr size_t WS_CQN = WS_R + 306 * MiB, WS_CKVN = WS_R + 330 * MiB;
constexpr size_t WS_H = WS_R;
constexpr size_t WS_WGUM = WS_R, WS_WDM = WS_R + 112 * MiB, WS_HM = WS_R + 168 * MiB;
constexpr size_t WS_END = WS_R + 394 * MiB;
constexpr int CW_TMO = 0, CW_BAR = 4096, CW_CNT = 8192;

constexpr int RING_BYTES = 131072, MISC_OFF = RING_BYTES, LDS_BYTES = 147456;

__device__ __forceinline__ unsigned f2bf(float f) { unsigned u = __builtin_bit_cast(unsigned, f); return (u + 0x7fffu + ((u >> 16) & 1u)) >> 16; }
__device__ __forceinline__ unsigned pk2(float lo, float hi) { unsigned r; asm volatile("v_cvt_pk_bf16_f32 %0, %1, %2" : "=v"(r) : "v"(lo), "v"(hi)); return r; }
__device__ __forceinline__ float bf2f(unsigned short b) { return __builtin_bit_cast(float, (unsigned)b << 16); }
__device__ __forceinline__ float bflo(unsigned w) { return __builtin_bit_cast(float, w << 16); }
__device__ __forceinline__ float bfhi(unsigned w) { return __builtin_bit_cast(float, w & 0xffff0000u); }
__device__ __forceinline__ float wave_sum(float v) {
#pragma unroll
    for (int o = 1; o < 64; o <<= 1) v += __shfl_xor(v, o);
    return v;
}
__device__ __forceinline__ float sigmoidf_(float x) { return __builtin_amdgcn_rcpf(1.0f + __builtin_amdgcn_exp2f(-1.4426950408889634f * x)); }
__device__ __forceinline__ float gelu_tanh(float x) { const float u2 = 1.5957691216057308f * (x + 0.044715f * x * x * x); return x * __builtin_amdgcn_rcpf(1.0f + __builtin_amdgcn_exp2f(-1.4426950408889634f * u2)); }
#define LDS_WAIT() asm volatile("s_waitcnt lgkmcnt(0)" ::: "memory")
#define VM_WAIT() asm volatile("s_waitcnt vmcnt(0)" ::: "memory")

namespace pg8 {
constexpr int BM = 256, BK = 64, HALF = 128, HTB = HALF * BK * 2, STAGE_BYTES = 8 * HTB, NXCD = 8, WGM = 8;
__host__ __device__ __forceinline__ int lds_byte(int r, int c) { const int st = (r >> 4) * 2 + (c >> 5), rr = r & 15, cc = c & 31, ob = rr * 64 + cc * 2; return st * 1024 + (ob ^ (((ob >> 9) & 1) << 5)); }
__host__ __device__ __forceinline__ void stage_rc(int b, int& R, int& C) { const int st = b / 1024, sb = b % 1024, swz = sb ^ (((sb >> 9) & 1) << 5); R = (st >> 1) * 16 + swz / 64; C = (st & 1) * 32 + (swz % 64) / 2; }
__host__ __device__ __forceinline__ int perm32(int rho) { const int n = rho >> 4, i = rho & 15; return 8 * (i >> 2) + 4 * n + (i & 3); }

struct Unit { int pm, pn, e, valid, rowbase, lbase; };
struct Gemm { const bf16_t* A; const bf16_t* Bt; int lda, ldb, K; };

struct StaticOrder {
    int nM, nN, nwg, G, c; size_t astep, bstep;
    __device__ void init(int M, int N, int G_, int c_, int lda, int ldb) { nM = M / BM; nN = N / BM; nwg = nM * nN; G = G_; c = c_; astep = (size_t)BM * lda * 2; bstep = (size_t)BM * ldb * 2; }
    __device__ bool next(int i, Unit& u) const {
        const long L = (long)i * G + c; if (L >= nwg) return false;
        int wgid = (int)L; { const int q = nwg / NXCD, r = nwg % NXCD, xcd = wgid % NXCD, off = wgid / NXCD; wgid = (xcd < r ? xcd * (q + 1) : r * (q + 1) + (xcd - r) * q) + off; }
        const int nig = WGM * nN, gid = wgid / nig, fm = gid * WGM, gsz = (nM - fm) < WGM ? (nM - fm) : WGM;
        u.pm = fm + ((wgid % nig) % gsz); u.pn = (wgid % nig) / gsz; u.e = 0; u.valid = 256; u.rowbase = u.pm * BM; u.lbase = 0; return true;
    }
    __device__ __forceinline__ size_t a_off(const Unit& u) const { return (size_t)u.pm * astep; }
    __device__ __forceinline__ size_t b_off(const Unit& u) const { return (size_t)u.pn * bstep; }
    __device__ __forceinline__ int row_tok(const Unit&, int) const { return 0; }
};

struct MoeOrder {
    int G, c, nN, pass; const unsigned* counts; const int* list; size_t bexp, bstep, astep;
    __device__ void init(const unsigned* counts_, int pass_, int nN_, int G_, int c_, const int* list_, int, int lda, int ldb, size_t bexp_) {
        G = G_; c = c_; nN = nN_; pass = pass_; list = list_; counts = counts_ + pass_ * 8; bexp = bexp_; bstep = (size_t)BM * ldb * 2; astep = (size_t)lda * 2;
    }
    __device__ bool next(int i, Unit& u) const {
        const int L = i * G + c;
        int e = -1, c0 = 0, np = 1, cn = 0, s0 = 0, a = 0, s = 0;
#pragma unroll
        for (int k = 0; k < 8; ++k) { const int n = __builtin_amdgcn_readfirstlane((int)__hip_atomic_load(counts + k, __ATOMIC_RELAXED, __HIP_MEMORY_SCOPE_AGENT)); const int npk = (n + 255) >> 8;
            if (L >= a * nN && L < (a + npk) * nN) { e = k; c0 = a; np = npk; cn = n; s0 = s; }
            a += npk; s += n; }
        if (e < 0) return false;
        const int le = L - c0 * nN; const int pn = le / np, j = le % np;
        u.e = e; u.pn = pn; u.pm = j; u.valid = (cn - 256 * j) < 256 ? (cn - 256 * j) : 256; u.rowbase = s0 + 256 * j; u.lbase = (pass * 8 + e) * NTOK + 256 * j; return true;
    }
    __device__ __forceinline__ size_t a_off(const Unit& u) const { return (size_t)u.rowbase * astep; }
    __device__ __forceinline__ size_t b_off(const Unit& u) const { return (size_t)u.e * bexp + (size_t)u.pn * bstep; }
    __device__ __forceinline__ int row_tok(const Unit& u, int R) const { return (R < u.valid) ? list[u.lbase + R] : 0; }
};

template <class Epi, class Sched, bool ALIGN_EPI, bool GATHER>
__device__ __forceinline__ void gemm_phase(LAS unsigned char* lds, const Gemm g, const Sched& S, const Epi& E) {
    int tid_ = threadIdx.x; asm volatile("" : "+v"(tid_));
    const int tid = tid_, wid = __builtin_amdgcn_readfirstlane(tid >> 6), lane = tid & 63, wr = wid >> 2, wc = wid & 3, fr = lane & 15, fq = lane >> 4;
    const int K = g.K, nt = K / BK;
    unsigned voffA[2], voffB[2]; int RA0, CA0;
#pragma unroll
    for (int i = 0; i < 2; ++i) { int R, C; stage_rc(tid * 16 + i * 8192, R, C); const int Rb = Epi::PERM ? ((R & ~31) + perm32(R & 31)) : R;
        if (i == 0) { RA0 = R; CA0 = C; } voffA[i] = (unsigned)(R * g.lda + C) * 2u; voffB[i] = (unsigned)(Rb * g.ldb + C) * 2u; }
    LAS int* tokt = (LAS int*)(lds + STAGE_BYTES + 1024);
    const size_t kstep = (size_t)(BK * 2);
    const size_t hstepA = GATHER ? 0 : (size_t)HALF * g.lda * 2, hstepB = (size_t)HALF * g.ldb * 2;
    const unsigned ldsw = (unsigned)wid * 1024u;
    const int aoff = lds_byte(wr * 64 + fr, fq * 8), boff = lds_byte(wc * 32 + fr, fq * 8);
#define PG8_SA(b, h) (((b) * 2 + (h)) * HTB)
#define PG8_SB(b, h) ((4 + (b) * 2 + (h)) * HTB)
#define PG8_STAGE(bufoff, gbase, v0, v1) do { \
        __builtin_amdgcn_global_load_lds((const unsigned*)((const char*)(gbase) + (v0)), (LAS unsigned*)(lds + (bufoff) + ldsw), 16, 0, 0); \
        __builtin_amdgcn_global_load_lds((const unsigned*)((const char*)(gbase) + (v1)), (LAS unsigned*)(lds + (bufoff) + ldsw + 8192), 16, 0, 0); } while (0)
#define PG8_STAGEB(bufoff, gbase) PG8_STAGE(bufoff, gbase, voffB[0], voffB[1])
#define PG8_STAGEA(bufoff, gbase, h, nx) do { if constexpr (GATHER) { const LAS int* tt_ = tokt + (((ui + ((nx) ? 1 : 0)) & 1) << 8) + (h) * HALF + RA0; \
            const unsigned o0_ = (unsigned)tt_[0] * (unsigned)(g.lda * 2) + (unsigned)(CA0 * 2), o1_ = (unsigned)tt_[64] * (unsigned)(g.lda * 2) + (unsigned)(CA0 * 2); PG8_STAGE(bufoff, gbase, o0_, o1_); } \
        else PG8_STAGE(bufoff, (gbase) + (h) * hstepA, voffA[0], voffA[1]); } while (0)
#define PG8_LDA(dst, b, h) do { _Pragma("unroll") for (int m = 0; m < 4; ++m) _Pragma("unroll") for (int k = 0; k < 2; ++k) dst[m][k] = *(const LAS bf16x8*)(lds + PG8_SA(b, h) + aoff + m * 2048 + k * 1024); } while (0)
#define PG8_LDB(dst, b, h) do { _Pragma("unroll") for (int n = 0; n < 2; ++n) _Pragma("unroll") for (int k = 0; k < 2; ++k) dst[n][k] = *(const LAS bf16x8*)(lds + PG8_SB(b, h) + boff + n * 2048 + k * 1024); } while (0)
#define PG8_MMA(ai, bj, At, Bt) do { __builtin_amdgcn_s_setprio(1); _Pragma("unroll") for (int m = 0; m < 4; ++m) _Pragma("unroll") for (int n = 0; n < 2; ++n) _Pragma("unroll") for (int k = 0; k < 2; ++k) \
        acc[ai][bj][m][n] = __builtin_amdgcn_mfma_f32_16x16x32_bf16(Bt[n][k], At[m][k], acc[ai][bj][m][n], 0, 0, 0); __builtin_amdgcn_s_setprio(0); } while (0)
#define PG8_WAIT_V(n) asm volatile("s_waitcnt vmcnt(" #n ")" ::: "memory")
#define PG8_WAIT_L(n) asm volatile("s_waitcnt lgkmcnt(" #n ")" ::: "memory")
#define PG8_BAR __builtin_amdgcn_s_barrier()
#define PG8_SCHED __builtin_amdgcn_sched_barrier(0)
#define PG8_GTOK(u, slot) do { if constexpr (GATHER) { if (tid < 256) tokt[((slot) & 1) * 256 + tid] = S.row_tok(u, tid); } } while (0)
    Unit cur, nxt; int ui = 0;
    if (!S.next(0, cur)) return;
    f32x4 acc[2][2][4][2];
#pragma unroll
    for (int a = 0; a < 2; ++a)
#pragma unroll
        for (int b = 0; b < 2; ++b)
#pragma unroll
            for (int m = 0; m < 4; ++m)
#pragma unroll
                for (int n = 0; n < 2; ++n) acc[a][b][m][n] = (f32x4){0.f, 0.f, 0.f, 0.f};
    bf16x8 At[4][2], B0[2][2], B1[2][2];
    const char* cA = (const char*)g.A + (GATHER ? (size_t)0 : S.a_off(cur)); const char* cB = (const char*)g.Bt + S.b_off(cur);
    if constexpr (GATHER) { PG8_GTOK(cur, 0); asm volatile("s_waitcnt lgkmcnt(0)" ::: "memory"); __builtin_amdgcn_s_barrier(); asm volatile("" ::: "memory"); }
    PG8_STAGEB(PG8_SB(0, 0), cB); PG8_STAGEB(PG8_SB(0, 1), cB + hstepB); PG8_STAGEA(PG8_SA(0, 0), cA, 0, false); PG8_STAGEA(PG8_SA(0, 1), cA, 1, false);
    if (wr == 1) PG8_BAR;
    PG8_WAIT_V(2); PG8_BAR;
    PG8_STAGEB(PG8_SB(1, 0), cB + kstep); PG8_STAGEA(PG8_SA(1, 0), cA + kstep, 0, false); PG8_STAGEB(PG8_SB(1, 1), cB + hstepB + kstep);
    PG8_WAIT_V(6); PG8_BAR;
    for (;;) {
        const bool has_next = S.next(ui + 1, nxt);
        const char* nA = has_next ? (const char*)g.A + (GATHER ? (size_t)0 : S.a_off(nxt)) : cA; const char* nB = has_next ? (const char*)g.Bt + S.b_off(nxt) : cB;
        if constexpr (GATHER) { if (has_next) PG8_GTOK(nxt, ui + 1); else PG8_GTOK(cur, ui + 1); }
#pragma unroll 1
        for (int t = 0; t < nt; t += 2) {
            const bool last = (t == nt - 2);
            const char* a1 = cA + (size_t)(t + 1) * kstep;
            const char* a2 = last ? nA : cA + (size_t)(t + 2) * kstep; const char* b2 = last ? nB : cB + (size_t)(t + 2) * kstep;
            const char* a3 = a2 + kstep; const char* b3 = b2 + kstep;
            PG8_LDB(B0, 0, 0); PG8_LDB(B1, 0, 1); PG8_SCHED; PG8_LDA(At, 0, 0); PG8_STAGEA(PG8_SA(1, 1), a1, 1, false);
            PG8_WAIT_V(8); PG8_WAIT_L(0); PG8_BAR; PG8_MMA(0, 0, At, B0); PG8_MMA(0, 1, At, B1); PG8_BAR; PG8_SCHED;
            PG8_LDA(At, 0, 1); PG8_STAGEB(PG8_SB(0, 0), b2); PG8_STAGEB(PG8_SB(0, 1), b2 + hstepB); PG8_STAGEA(PG8_SA(0, 0), a2, 0, last);
            PG8_WAIT_V(8); PG8_WAIT_L(0); PG8_BAR; PG8_MMA(1, 0, At, B0); PG8_MMA(1, 1, At, B1); PG8_BAR; PG8_SCHED;
            PG8_LDB(B0, 1, 0); PG8_LDB(B1, 1, 1); PG8_SCHED; PG8_LDA(At, 1, 0); PG8_STAGEA(PG8_SA(0, 1), a2, 1, last);
            PG8_WAIT_V(8); PG8_WAIT_L(0); PG8_BAR; PG8_MMA(0, 0, At, B0); PG8_MMA(0, 1, At, B1); PG8_BAR; PG8_SCHED;
            PG8_LDA(At, 1, 1); PG8_STAGEB(PG8_SB(1, 0), b3); PG8_STAGEB(PG8_SB(1, 1), b3 + hstepB); PG8_STAGEA(PG8_SA(1, 0), a3, 0, last);
            PG8_WAIT_V(8); PG8_WAIT_L(0); PG8_BAR; PG8_MMA(1, 0, At, B0); PG8_MMA(1, 1, At, B1); PG8_BAR; PG8_SCHED;
        }
        if constexpr (ALIGN_EPI) { if (wr == 0) PG8_BAR; }
        E(acc, cur, wr, wc, fr, fq);
        if (!has_next) break;
#pragma unroll
        for (int a = 0; a < 2; ++a)
#pragma unroll
            for (int b = 0; b < 2; ++b)
#pragma unroll
                for (int m = 0; m < 4; ++m)
#pragma unroll
                    for (int n = 0; n < 2; ++n) acc[a][b][m][n] = (f32x4){0.f, 0.f, 0.f, 0.f};
        cur = nxt; cA = nA; cB = nB; ++ui;
        if constexpr (ALIGN_EPI) { if (wr == 1) PG8_BAR; }
    }
    PG8_WAIT_V(0);
    if constexpr (!ALIGN_EPI) { if (wr == 0) PG8_BAR; }
    PG8_BAR;
#undef PG8_SA
#undef PG8_SB
#undef PG8_STAGE
#undef PG8_STAGEA
#undef PG8_STAGEB
#undef PG8_LDA
#undef PG8_LDB
#undef PG8_MMA
#undef PG8_WAIT_V
#undef PG8_WAIT_L
#undef PG8_BAR
#undef PG8_SCHED
#undef PG8_GTOK
}
}
using pg8::Unit;

typedef f32x4 Acc[2][2][4][2];
struct EpiStore {
    static constexpr bool PERM = true;
    bf16_t* O; int ldc; const float* rowscale;
    __device__ __forceinline__ void operator()(Acc& acc, const Unit& u, int wr, int wc, int fr, int fq) const {
        const int row0 = u.pm * 256 + wr * 64 + fr, col0 = u.pn * 256 + wc * 32 + 8 * fq;
#pragma unroll
        for (int ai = 0; ai < 2; ++ai)
#pragma unroll
            for (int m = 0; m < 4; ++m) { const int row = row0 + ai * 128 + m * 16; const float s = rowscale ? rowscale[row] : 1.f;
                asm volatile("" : "+v"(acc[ai][0][m][0]), "+v"(acc[ai][0][m][1]), "+v"(acc[ai][1][m][0]), "+v"(acc[ai][1][m][1])); bf16_t* rowp = O + ((unsigned)row * (unsigned)ldc + (unsigned)col0);
#pragma unroll
                for (int bj = 0; bj < 2; ++bj) { const f32x4 v0 = acc[ai][bj][m][0] * s, v1 = acc[ai][bj][m][1] * s;
                    u32x4 w; w.x = pk2(v0[0], v0[1]); w.y = pk2(v0[2], v0[3]); w.z = pk2(v1[0], v1[1]); w.w = pk2(v1[2], v1[3]);
                    *(u32x4*)(rowp + bj * 128) = w; } }
    }
};
struct EpiQ {
    static constexpr bool PERM = false;
    bf16_t* Q; const f32x2* rope;
    __device__ __forceinline__ void operator()(Acc& acc, const Unit& u, int wr, int wc, int fr, int fq) const {
#pragma unroll
        for (int ai = 0; ai < 2; ++ai)
#pragma unroll
            for (int m = 0; m < 4; ++m) { const int row = u.pm * 256 + ai * 128 + wr * 64 + m * 16 + fr; const int pos = row & (SEQ - 1);
                asm volatile("" : "+v"(acc[ai][0][m][0]), "+v"(acc[ai][0][m][1]), "+v"(acc[ai][1][m][0]), "+v"(acc[ai][1][m][1]));
                const f32x4 t0 = *(const f32x4*)(rope + ((unsigned)pos * 16u + 4u * fq)), t1 = *(const f32x4*)(rope + ((unsigned)pos * 16u + 4u * fq + 2u));
                const float cs[4] = {t0[0], t0[2], t1[0], t1[2]}, sn[4] = {t0[1], t0[3], t1[1], t1[3]};
#pragma unroll
                for (int bj = 0; bj < 2; ++bj) { const int cg = u.pn * 256 + bj * 128 + wc * 32; const bool isrope = ((cg >> 5) % 3) == 2;
                    f32x4 v0 = acc[ai][bj][m][0], v1 = acc[ai][bj][m][1];
                    if (isrope) {
#pragma unroll
                        for (int e = 0; e < 4; ++e) { const float x1 = v0[e], x2 = v1[e]; v0[e] = x1 * cs[e] - x2 * sn[e]; v1[e] = x2 * cs[e] + x1 * sn[e]; } }
                    u32x2 w0, w1; w0.x = pk2(v0[0], v0[1]); w0.y = pk2(v0[2], v0[3]); w1.x = pk2(v1[0], v1[1]); w1.y = pk2(v1[2], v1[3]);
                    bf16_t* p = Q + ((unsigned)row * (unsigned)QW + (unsigned)(cg + 4 * fq)); *(u32x2*)p = w0; *(u32x2*)(p + 16) = w1; }
                asm volatile("" ::: "memory"); }
    }
};
struct EpiVT {
    static constexpr bool PERM = true;
    bf16_t* VT;
    __device__ __forceinline__ void operator()(Acc& acc, const Unit& u, int wr, int wc, int fr, int fq) const {
#pragma unroll
        for (int bj = 0; bj < 2; ++bj) { const int tb = u.pn * 256 + bj * 128 + wc * 32 + 8 * fq; const int base16 = tb & ~15, c = (tb >> 3) & 1;
#pragma unroll
            for (int ai = 0; ai < 2; ++ai)
#pragma unroll
                for (int m = 0; m < 4; ++m) { const int f = u.pm * 256 + ai * 128 + wr * 64 + m * 16 + fr; asm volatile("" : "+v"(acc[ai][bj][m][0]), "+v"(acc[ai][bj][m][1])); const f32x4 v0 = acc[ai][bj][m][0], v1 = acc[ai][bj][m][1];
                    u32x2 w0, w1; w0.x = pk2(v0[0], v0[1]); w0.y = pk2(v0[2], v0[3]); w1.x = pk2(v1[0], v1[1]); w1.y = pk2(v1[2], v1[3]);
                    bf16_t* p = VT + ((unsigned)f * (unsigned)NTOK + (unsigned)(base16 + 4 * c)); *(u32x2*)p = w0; *(u32x2*)(p + 8) = w1; asm volatile("" ::: "memory"); } }
    }
};
struct EpiResid {
    static constexpr bool PERM = false;
    float* X;
    __device__ __forceinline__ void operator()(Acc& acc, const Unit& u, int wr, int wc, int fr, int fq) const {
        const int col0 = u.pn * 256 + wc * 32 + 4 * fq;
#pragma unroll
        for (int ai = 0; ai < 2; ++ai)
#pragma unroll
            for (int m = 0; m < 4; ++m) { const int row = u.pm * 256 + ai * 128 + wr * 64 + m * 16 + fr; float* rp = X + ((unsigned)row * (unsigned)DM + (unsigned)col0);
#pragma unroll
                for (int bj = 0; bj < 2; ++bj)
#pragma unroll
                    for (int n = 0; n < 2; ++n) { f32x4* p = (f32x4*)(rp + bj * 128 + n * 16); const f32x4 x = *p; *p = x * DN_ALPHA + acc[ai][bj][m][n]; } }
    }
};
struct EpiSwiglu {
    static constexpr bool PERM = true;
    bf16_t* H;
    __device__ __forceinline__ void operator()(Acc& acc, const Unit& u, int wr, int wc, int fr, int fq) const {
        const int colh = u.pn * 128 + wc * 32 + 8 * fq;
#pragma unroll
        for (int ai = 0; ai < 2; ++ai)
#pragma unroll
            for (int m = 0; m < 4; ++m) { const int rt = ai * 128 + wr * 64 + m * 16 + fr;
                asm volatile("" : "+v"(acc[ai][0][m][0]), "+v"(acc[ai][0][m][1]), "+v"(acc[ai][1][m][0]), "+v"(acc[ai][1][m][1]));
                float hv[8];
#pragma unroll
                for (int n = 0; n < 2; ++n)
#pragma unroll
                    for (int e = 0; e < 4; ++e) { const float g = acc[ai][0][m][n][e], up = acc[ai][1][m][n][e]; hv[4 * n + e] = g * __builtin_amdgcn_rcpf(1.0f + __expf(-g)) * up; }
                u32x4 w; w.x = pk2(hv[0], hv[1]); w.y = pk2(hv[2], hv[3]); w.z = pk2(hv[4], hv[5]); w.w = pk2(hv[6], hv[7]);
                if (rt < u.valid) *(u32x4*)(H + ((unsigned)(u.rowbase + rt) * (unsigned)DFF + (unsigned)colh)) = w; asm volatile("" ::: "memory"); }
    }
};
struct EpiMoeDown {
    static constexpr bool PERM = false;
    float* X; const int* list; const float* glist; int pass;
    __device__ __forceinline__ void operator()(Acc& acc, const Unit& u, int wr, int wc, int fr, int fq) const {
        const int col0 = u.pn * 256 + wc * 32 + 4 * fq; const float al = pass == 0 ? DN_ALPHA : 1.0f;
#pragma unroll
        for (int ai = 0; ai < 2; ++ai)
#pragma unroll
            for (int m = 0; m < 4; ++m) { const int rt = ai * 128 + wr * 64 + m * 16 + fr;
                if (rt < u.valid) { const int tok = list[u.lbase + rt]; const float gt = glist[u.lbase + rt]; float* rp = X + ((unsigned)tok * (unsigned)DM + (unsigned)col0);
#pragma unroll
                    for (int bj = 0; bj < 2; ++bj)
#pragma unroll
                        for (int n = 0; n < 2; ++n) { f32x4* p = (f32x4*)(rp + bj * 128 + n * 16); const f32x4 x = *p; *p = x * al + acc[ai][bj][m][n] * gt; } } }
    }
};

namespace att {
constexpr int KVB = 64, NT = SEQ / KVB, STG = 20480, NSTG = 4;
typedef __bf16 bf16x2_t __attribute__((ext_vector_type(2)));
__device__ __forceinline__ void glds16(const void* gsrc, unsigned lds_dst) { unsigned keep;
    asm volatile("s_mov_b32 %0, m0\n\ts_mov_b32 m0, %2\n\ts_nop 0\n\tglobal_load_lds_dwordx4 %1, off\n\ts_mov_b32 m0, %0" : "=&s"(keep) : "v"(gsrc), "s"(lds_dst) : "memory"); }
__device__ __forceinline__ void attn_unit(int b, int h, int qb, const bf16_t* Q, const bf16_t* Kn, const bf16_t* Kr, const bf16_t* VT, bf16_t* Y, LAS unsigned char* lds) {
    int tid_ = threadIdx.x; asm volatile("" : "+v"(tid_));
    const int tid = tid_, lane = tid & 63, r32 = lane & 31, hi = lane >> 5; const int wid = __builtin_amdgcn_readfirstlane(tid >> 6);
    const size_t rowbase = (size_t)b * SEQ; const int q0 = qb * 256 + wid * 32;
    bf16x8 qf[6];
    { const bf16_t* qp = Q + (rowbase + q0 + r32) * QW + h * 96 + hi * 8;
#pragma unroll
      for (int d0 = 0; d0 < 6; ++d0) qf[d0] = *(const bf16x8*)(qp + d0 * 16); }
    const char* s0 = (const char*)(Kn + (rowbase + lane) * 512 + h * 64 + wid * 8);
    const char* s1; const char* s2; size_t st1;
    if (wid < 4) { s1 = (const char*)(Kr + (rowbase + lane) * 32 + wid * 8); st1 = (size_t)KVB * 32 * 2;
                   s2 = (const char*)(VT + (size_t)(h * 64 + 32 + r32) * NTOK + rowbase + wid * 16 + hi * 8); }
    else { s1 = (const char*)(VT + (size_t)(h * 64 + r32) * NTOK + rowbase + (wid - 4) * 16 + hi * 8); st1 = (size_t)KVB * 2; s2 = s1; }
    const size_t st0 = (size_t)KVB * 512 * 2, st2 = (size_t)KVB * 2;
    const unsigned lds0 = (unsigned)(uintptr_t)lds;
    const unsigned d0off = (unsigned)wid * 1024u, d1off = (wid < 4) ? (unsigned)(8 + wid) * 1024u : (unsigned)(12 + wid - 4) * 1024u, d2off = (unsigned)(16 + wid) * 1024u;
#define ATT_DMA(t, stg) do { const unsigned sb_ = lds0 + (unsigned)(stg) * STG; \
        glds16(s0 + (size_t)(t) * st0, (unsigned)__builtin_amdgcn_readfirstlane(sb_ + d0off)); \
        glds16(s1 + (size_t)(t) * st1, (unsigned)__builtin_amdgcn_readfirstlane(sb_ + d1off)); \
        if (wid < 4) glds16(s2 + (size_t)(t) * st2, (unsigned)__builtin_amdgcn_readfirstlane(sb_ + d2off)); } while (0)
    float m_run = 0.f, l_run = 0.f; f32x16 o0, o1, negm;
#pragma unroll
    for (int r = 0; r < 16; ++r) { o0[r] = 0.f; o1[r] = 0.f; negm[r] = 0.f; }
    ATT_DMA(0, 0); ATT_DMA(1, 1); ATT_DMA(2, 2);
    if (wid < 4) asm volatile("s_waitcnt vmcnt(6)" ::: "memory"); else asm volatile("s_waitcnt vmcnt(4)" ::: "memory");
    asm volatile("s_barrier" ::: "memory");
    f32x16 p0 = negm, p1 = negm;
#define ATT_QK(P0, P1, Kst) do { _Pragma("unroll") for (int d0 = 0; d0 < 6; ++d0) { \
            const bf16x8 a0_ = *(const LAS bf16x8*)((Kst) + (2 * d0 + hi) * 1024 + r32 * 16); \
            const bf16x8 a1_ = *(const LAS bf16x8*)((Kst) + (2 * d0 + hi) * 1024 + 512 + r32 * 16); \
            P0 = __builtin_amdgcn_mfma_f32_32x32x16_bf16(a0_, qf[d0], P0, 0, 0, 0); \
            P1 = __builtin_amdgcn_mfma_f32_32x32x16_bf16(a1_, qf[d0], P1, 0, 0, 0); } } while (0)
    ATT_QK(p0, p1, lds);
#define MX3(a, b, c) __builtin_fmaxf(__builtin_fmaxf((a), (b)), (c))
#define ATT_MAXFIX(P0, P1, FIRST) do { \
        float ma_ = MX3(P0[0], P0[1], P1[0]), mb_ = MX3(P0[2], P0[3], P1[1]); ma_ = MX3(ma_, P1[2], P1[3]); \
        _Pragma("unroll") for (int r = 4; r < 16; r += 4) { ma_ = MX3(ma_, P0[r], P0[r + 1]); mb_ = MX3(mb_, P0[r + 2], P0[r + 3]); ma_ = MX3(ma_, P1[r], P1[r + 1]); mb_ = MX3(mb_, P1[r + 2], P1[r + 3]); } \
        float mx_ = __builtin_fmaxf(ma_, mb_); \
        { auto rr_ = __builtin_amdgcn_permlane32_swap(__float_as_uint(mx_), __float_as_uint(mx_), false, false); mx_ = __builtin_fmaxf(__uint_as_float(rr_[0]), __uint_as_float(rr_[1])); } \
        if ((FIRST) || __any(mx_ > 8.0f)) { const float dl_ = (FIRST) ? mx_ : __builtin_fmaxf(mx_, 0.f); m_run += dl_; const float al_ = __builtin_amdgcn_exp2f(-dl_); l_run *= al_; \
            _Pragma("unroll") for (int r = 0; r < 16; ++r) { P0[r] -= dl_; P1[r] -= dl_; o0[r] *= al_; o1[r] *= al_; negm[r] = -m_run; } } } while (0)
    ATT_MAXFIX(p0, p1, true);
    int stg = 0;
#pragma unroll 1
    for (int t = 0; t < NT; ++t) {
        if (t + 2 < NT) { if (wid < 4) asm volatile("s_waitcnt vmcnt(3)" ::: "memory"); else asm volatile("s_waitcnt vmcnt(2)" ::: "memory"); }
        else asm volatile("s_waitcnt vmcnt(0)" ::: "memory");
        asm volatile("s_barrier" ::: "memory");
        if (t + 3 < NT) { const int s3 = (stg == 0) ? 3 : stg - 1; ATT_DMA(t + 3, s3); }
        const LAS unsigned char* Ks = lds + stg * STG;
        const LAS unsigned char* Kn1 = lds + ((stg == 3) ? 0 : stg + 1) * STG;
        f32x16 n0 = negm, n1 = negm;
        ATT_QK(n0, n1, Kn1);
        float ls0 = 0.f, ls1 = 0.f, ls2 = 0.f, ls3 = 0.f;
#pragma unroll
        for (int r = 0; r < 16; r += 2) { p0[r] = __builtin_amdgcn_exp2f(p0[r]); p1[r] = __builtin_amdgcn_exp2f(p1[r]); p0[r + 1] = __builtin_amdgcn_exp2f(p0[r + 1]); p1[r + 1] = __builtin_amdgcn_exp2f(p1[r + 1]);
            ls0 += p0[r]; ls1 += p1[r]; ls2 += p0[r + 1]; ls3 += p1[r + 1]; }
        l_run += (ls0 + ls1) + (ls2 + ls3);
        bf16x8 pb[4];
#define CV2(a, b) __builtin_bit_cast(unsigned, __builtin_convertvector((f32x2){(a), (b)}, bf16x2_t))
        { u32x4 w;
          w.x = CV2(p0[0], p0[1]); w.y = CV2(p0[2], p0[3]); w.z = CV2(p0[4], p0[5]); w.w = CV2(p0[6], p0[7]); pb[0] = __builtin_bit_cast(bf16x8, w);
          w.x = CV2(p0[8], p0[9]); w.y = CV2(p0[10], p0[11]); w.z = CV2(p0[12], p0[13]); w.w = CV2(p0[14], p0[15]); pb[1] = __builtin_bit_cast(bf16x8, w);
          w.x = CV2(p1[0], p1[1]); w.y = CV2(p1[2], p1[3]); w.z = CV2(p1[4], p1[5]); w.w = CV2(p1[6], p1[7]); pb[2] = __builtin_bit_cast(bf16x8, w);
          w.x = CV2(p1[8], p1[9]); w.y = CV2(p1[10], p1[11]); w.z = CV2(p1[12], p1[13]); w.w = CV2(p1[14], p1[15]); pb[3] = __builtin_bit_cast(bf16x8, w); }
#undef CV2
        const LAS unsigned char* Vs = Ks + 12288 + lane * 16;
#pragma unroll
        for (int ks = 0; ks < 4; ++ks) {
            const bf16x8 v0 = *(const LAS bf16x8*)(Vs + ks * 1024);
            const bf16x8 v1 = *(const LAS bf16x8*)(Vs + (4 + ks) * 1024);
            o0 = __builtin_amdgcn_mfma_f32_32x32x16_bf16(v0, pb[ks], o0, 0, 0, 0);
            o1 = __builtin_amdgcn_mfma_f32_32x32x16_bf16(v1, pb[ks], o1, 0, 0, 0);
        }
#if ATT_SCHED
        __builtin_amdgcn_sched_group_barrier(0x100, 12, 0);
#pragma unroll
        for (int i = 0; i < 6; ++i) { __builtin_amdgcn_sched_group_barrier(0x008, 1, 0); __builtin_amdgcn_sched_group_barrier(0x002, 5, 0); }
        __builtin_amdgcn_sched_group_barrier(0x100, 8, 0);
#pragma unroll
        for (int i = 0; i < 6; ++i) { __builtin_amdgcn_sched_group_barrier(0x008, 1, 0); __builtin_amdgcn_sched_group_barrier(0x002, 5, 0); }
#pragma unroll
        for (int i = 0; i < 8; ++i) { __builtin_amdgcn_sched_group_barrier(0x008, 1, 0); __builtin_amdgcn_sched_group_barrier(0x002, 4, 0); }
#endif
        p0 = n0; p1 = n1;
        if (t + 1 < NT) ATT_MAXFIX(p0, p1, false);
        stg = (stg == 3) ? 0 : stg + 1;
    }
#undef MX3
#undef ATT_MAXFIX
#undef ATT_QK
#undef ATT_DMA
    const float l = l_run + __shfl_xor(l_run, 32); const float inv = 1.0f / l;
    bf16_t* yp = Y + (rowbase + q0 + r32) * DM + 256 + h * 64 + 4 * hi;
#pragma unroll
    for (int g = 0; g < 4; ++g) {
        u32x2 w0, w1; w0.x = pk2(o0[4 * g] * inv, o0[4 * g + 1] * inv); w0.y = pk2(o0[4 * g + 2] * inv, o0[4 * g + 3] * inv);
        w1.x = pk2(o1[4 * g] * inv, o1[4 * g + 1] * inv); w1.y = pk2(o1[4 * g + 2] * inv, o1[4 * g + 3] * inv);
        *(u32x2*)(yp + 8 * g) = w0; *(u32x2*)(yp + 32 + 8 * g) = w1; }
    asm volatile("s_waitcnt lgkmcnt(0)\n\ts_barrier" ::: "memory");
}
}

namespace lru {
constexpr int HS_BYTES = 65536, WST = 3 * 16 * 36 * 4;
template <int PASS>
__device__ __forceinline__ void lru_unit(int b, int ck, int layer, const bf16_t* Z, const bf16_t* LW, const float* c8sp, const float* convw, const float* convb, const float* ba, const float* bi,
                                         float* aggA, float* aggH, const float* glru, bf16_t* Y, LAS unsigned char* lds) {
    int tid_ = threadIdx.x; asm volatile("" : "+v"(tid_));
    const int tid = tid_, lane = tid & 63, fr = lane & 15, fq = lane >> 4; const int wid = __builtin_amdgcn_readfirstlane(tid >> 6);
    const int n = wid & 3, hf = wid >> 2, chbase = 64 * n, own = chbase + 32 * hf, c = lane & 31;
    LAS float* xs = (LAS float*)(lds + HS_BYTES + wid * WST); LAS float* as_ = xs + 16 * 36; LAS float* us = as_ + 16 * 36;
    LAS bf16_t* hs = (LAS bf16_t*)lds;
    const int tok0 = b * SEQ + ck * LRU_CH;
    float cw[4][16], cb[16];
#pragma unroll
    for (int e = 0; e < 16; ++e) { const int ch = chbase + (e >> 3) * 32 + 8 * fq + (e & 7); cb[e] = convb[layer * 256 + ch];
#pragma unroll
        for (int k = 0; k < 4; ++k) cw[k][e] = convw[(layer * 4 + k) * 256 + ch]; }
#pragma unroll 1
    for (int sweep = 0; sweep < 2; ++sweep) {
        const int d = (PASS == 2) ? 1 - sweep : sweep;
        bf16x8 wf[2][2][2];
#pragma unroll
        for (int g = 0; g < 2; ++g)
#pragma unroll
            for (int nt = 0; nt < 2; ++nt)
#pragma unroll
                for (int ks = 0; ks < 2; ++ks) wf[g][nt][ks] = *(const bf16x8*)(LW + ((size_t)((((layer * 2 + d) * 2 + g) * 4 + n) * 64 + 32 * hf + 16 * nt + fr)) * 64 + ks * 32 + 8 * fq);
        float bav[2][4], biv[2][4], spv[2][4];
#pragma unroll
        for (int nt = 0; nt < 2; ++nt)
#pragma unroll
            for (int e = 0; e < 4; ++e) { const int ch = own + 16 * nt + 4 * fq + e; bav[nt][e] = ba[(layer * 2 + d) * 256 + ch]; biv[nt][e] = bi[(layer * 2 + d) * 256 + ch]; spv[nt][e] = c8sp[(layer * 2 + d) * 256 + ch]; }
        float hst = 0.f, Pa = 1.f;
        if (PASS == 2) {
            const float* pa = aggA + (size_t)((b * 2 + d) * LRU_NCH) * 256 + own + c; const float* ph = aggH + (size_t)((b * 2 + d) * LRU_NCH) * 256 + own + c;
            const int nf = (d == 0) ? ck : (LRU_NCH - 1 - ck);
#pragma unroll 1
            for (int j0 = 0; j0 < nf; j0 += 8) { float A8[8], H8[8];
#pragma unroll
                for (int q = 0; q < 8; ++q) { const int jj = j0 + q; const bool ok = jj < nf; const int j = (d == 0) ? jj : (LRU_NCH - 1 - jj); const int jc = ok ? j : ck;
                    A8[q] = pa[(size_t)jc * 256]; H8[q] = ph[(size_t)jc * 256]; if (!ok) { A8[q] = 1.f; H8[q] = 0.f; } }
#pragma unroll
                for (int q = 0; q < 8; ++q) hst = A8[q] * hst + H8[q]; }
        }
#pragma unroll 1
        for (int s = 0; s < 8; ++s) {
            const int sb = (d == 0) ? s : 7 - s; const int t0 = tok0 + sb * 16;
            float xc[16];
#pragma unroll
            for (int e = 0; e < 16; ++e) xc[e] = cb[e];
#pragma unroll
            for (int k = 0; k < 4; ++k) { const int tk = t0 + fr + k - 1; const int pos = tk - b * SEQ;
                if (pos >= 0 && pos < SEQ) { const bf16_t* zp = Z + (size_t)tk * DINP + ZC_LX + chbase + 8 * fq; const u32x4 v0 = *(const u32x4*)zp, v1 = *(const u32x4*)(zp + 32);
                    xc[0] += cw[k][0] * bflo(v0.x); xc[1] += cw[k][1] * bfhi(v0.x); xc[2] += cw[k][2] * bflo(v0.y); xc[3] += cw[k][3] * bfhi(v0.y);
                    xc[4] += cw[k][4] * bflo(v0.z); xc[5] += cw[k][5] * bfhi(v0.z); xc[6] += cw[k][6] * bflo(v0.w); xc[7] += cw[k][7] * bfhi(v0.w);
                    xc[8] += cw[k][8] * bflo(v1.x); xc[9] += cw[k][9] * bfhi(v1.x); xc[10] += cw[k][10] * bflo(v1.y); xc[11] += cw[k][11] * bfhi(v1.y);
                    xc[12] += cw[k][12] * bflo(v1.z); xc[13] += cw[k][13] * bfhi(v1.z); xc[14] += cw[k][14] * bflo(v1.w); xc[15] += cw[k][15] * bfhi(v1.w); } }
            bf16x8 af0, af1;
            { u32x4 w; w.x = pk2(xc[0], xc[1]); w.y = pk2(xc[2], xc[3]); w.z = pk2(xc[4], xc[5]); w.w = pk2(xc[6], xc[7]); af0 = __builtin_bit_cast(bf16x8, w);
              w.x = pk2(xc[8], xc[9]); w.y = pk2(xc[10], xc[11]); w.z = pk2(xc[12], xc[13]); w.w = pk2(xc[14], xc[15]); af1 = __builtin_bit_cast(bf16x8, w); }
            { f32x4 x0, x1;
              if (hf == 0) { x0 = (f32x4){xc[0], xc[1], xc[2], xc[3]}; x1 = (f32x4){xc[4], xc[5], xc[6], xc[7]}; } else { x0 = (f32x4){xc[8], xc[9], xc[10], xc[11]}; x1 = (f32x4){xc[12], xc[13], xc[14], xc[15]}; }
              *(LAS f32x4*)(xs + fr * 36 + 8 * fq) = x0; *(LAS f32x4*)(xs + fr * 36 + 8 * fq + 4) = x1; }
#pragma unroll
            for (int nt = 0; nt < 2; ++nt) {
                f32x4 ga = (f32x4){0.f, 0.f, 0.f, 0.f}, gi = ga;
                ga = __builtin_amdgcn_mfma_f32_16x16x32_bf16(wf[0][nt][0], af0, ga, 0, 0, 0); ga = __builtin_amdgcn_mfma_f32_16x16x32_bf16(wf[0][nt][1], af1, ga, 0, 0, 0);
                gi = __builtin_amdgcn_mfma_f32_16x16x32_bf16(wf[1][nt][0], af0, gi, 0, 0, 0); gi = __builtin_amdgcn_mfma_f32_16x16x32_bf16(wf[1][nt][1], af1, gi, 0, 0, 0);
                f32x4 av, uv;
#pragma unroll
                for (int e = 0; e < 4; ++e) { const float rec = sigmoidf_(ga[e] + bav[nt][e]), inp = sigmoidf_(gi[e] + biv[nt][e]); const float la = -spv[nt][e] * rec;
                    const float aa = __builtin_amdgcn_exp2f(1.4426950408889634f * la); av[e] = aa; uv[e] = __builtin_amdgcn_sqrtf((1.0f - aa) * (1.0f + aa)) * inp; }
                *(LAS f32x4*)(as_ + fr * 36 + 16 * nt + 4 * fq) = av; *(LAS f32x4*)(us + fr * 36 + 16 * nt + 4 * fq) = uv;
            }
            LDS_WAIT();
            float lgv[16];
            if (PASS == 2 && d == 0) {
#pragma unroll
                for (int tt = 0; tt < 16; ++tt) lgv[tt] = bf2f(Z[(size_t)(tok0 + sb * 16 + tt) * DINP + ZC_LG + own + c]); }
            float a16[16], u16[16];
#pragma unroll
            for (int tt = 0; tt < 16; ++tt) { const int ti = (d == 0) ? tt : 15 - tt; a16[tt] = as_[ti * 36 + c]; u16[tt] = us[ti * 36 + c] * xs[ti * 36 + c]; }
#pragma unroll
            for (int tt = 0; tt < 16; ++tt) { const int ti = (d == 0) ? tt : 15 - tt;
                hst = a16[tt] * hst + u16[tt]; Pa *= a16[tt];
                if (PASS == 2) { const int row = sb * 16 + ti;
                    if (lane < 32) {
                        if (d == 1) hs[row * 256 + own + c] = (bf16_t)f2bf(hst);
                        else { const float hb = bf2f(hs[row * 256 + own + c]); hs[row * 256 + own + c] = (bf16_t)f2bf(gelu_tanh(lgv[tt]) * (hst + hb)); } } } }
            LDS_WAIT();
        }
        if (PASS == 1 && lane < 32) { const size_t o = (size_t)((b * 2 + d) * LRU_NCH + ck) * 256 + own + c; aggA[o] = Pa; aggH[o] = hst; }
    }
    if (PASS == 2) {
        __syncthreads();
#pragma unroll 1
        for (int i = 0; i < 16; ++i) { const int row = wid * 16 + i; const u32x2 w = *(const LAS u32x2*)(hs + row * 256 + 4 * lane);
            const float v0 = bflo(w.x), v1 = bfhi(w.x), v2 = bflo(w.y), v3 = bfhi(w.y);
            const float ss = wave_sum(v0 * v0 + v1 * v1 + v2 * v2 + v3 * v3); const float rs = rsqrtf(ss * (1.0f / 256.0f) + RMS_EPS);
            const f32x4 g = *(const f32x4*)(glru + 4 * lane);
            u32x2 o; o.x = pk2(v0 * rs * g[0], v1 * rs * g[1]); o.y = pk2(v2 * rs * g[2], v3 * rs * g[3]);
            *(u32x2*)(Y + (size_t)(tok0 + row) * DM + 768 + 4 * lane) = o; }
        __syncthreads();
    }
}
}

#define XB_TMO      128
#define XB_XCNT(j)  (256  + 64 * (j))
#define XB_XSUB(j)  (1280 + 64 * (j))
#define XB_XGEN(j)  (2304 + 64 * (j))
#define XB_TOP      3328
#define XB_TOPGEN   3392
#define XCD_BAR_WORDS 3456
#define XB_SPIN_CAP (1u << 18)
__device__ __forceinline__ unsigned xb_ld(unsigned* p)              { return __hip_atomic_load(p, __ATOMIC_RELAXED, __HIP_MEMORY_SCOPE_AGENT); }
__device__ __forceinline__ unsigned xb_add(unsigned* p, unsigned v) { return __hip_atomic_fetch_add(p, v, __ATOMIC_RELAXED, __HIP_MEMORY_SCOPE_AGENT); }
__device__ __forceinline__ unsigned xb_xcc_id() { return (unsigned)__builtin_amdgcn_s_getreg((3 << 11) | 20) & 0xFu; }
#define XB_SPIN(cond, bar) do { unsigned _sp = 0; while (cond) { __builtin_amdgcn_s_sleep(1); \
    if ((++_sp & 255u) == 0u) { if (xb_ld(&(bar)[XB_TMO])) break; if (_sp > XB_SPIN_CAP) { atomicAdd(&(bar)[XB_TMO], 1u); break; } } } } while (0)
struct XcdBarrier { unsigned* bar; unsigned x; volatile LAS unsigned* st; };
__device__ __forceinline__ XcdBarrier xcd_barrier_post(unsigned* bar, volatile LAS unsigned* st) {
    XcdBarrier b; b.bar = bar; b.x = xb_xcc_id(); b.st = st;
    if (threadIdx.x == 0) (void)xb_add(&bar[XB_XCNT(b.x)], 1u);
    return b;
}
__device__ __forceinline__ void xcd_barrier_complete(unsigned* bar, unsigned x, unsigned& nloc, unsigned& nx) {
    const unsigned G = gridDim.x * gridDim.y * gridDim.z;
    unsigned sum, cnt, mine, sp = 0u;
    for (;;) {
        sum = 0u; cnt = 0u; mine = 0u;
#pragma unroll
        for (unsigned j = 0; j < 16; ++j) { const unsigned c = xb_ld(&bar[XB_XCNT(j)]); sum += c; cnt += (c > 0u) ? 1u : 0u; mine = (j == x) ? c : mine; }
        if (sum == G) break;
        __builtin_amdgcn_s_sleep(1);
        if ((++sp & 255u) == 0u) { if (xb_ld(&bar[XB_TMO])) break; if (sp > XB_SPIN_CAP) { atomicAdd(&bar[XB_TMO], 1u); break; } }
    }
    nloc = mine > 0u ? mine : 1u; nx = cnt > 0u ? cnt : 1u;
}
__device__ __forceinline__ void xcd_barrier(const XcdBarrier& b) {
    asm volatile("s_waitcnt vmcnt(0)" ::: "memory");
    __syncthreads();
    if (threadIdx.x == 0) {
        unsigned* bar = b.bar;
        __builtin_amdgcn_s_waitcnt(0);
        unsigned nloc = b.st[0], nx = b.st[1];
        if (nloc == 0u) { xcd_barrier_complete(bar, b.x, nloc, nx); b.st[0] = nloc; b.st[1] = nx; }
        const unsigned old = xb_add(&bar[XB_XSUB(b.x)], 1u);
        const unsigned gen = old / nloc;
        if (old + 1u == (gen + 1u) * nloc) {
            __builtin_amdgcn_fence(__ATOMIC_RELEASE, "agent");
            asm volatile("s_waitcnt vmcnt(0)" ::: "memory");
            const unsigned og = xb_add(&bar[XB_TOP], 1u);
            const unsigned tg = og / nx;
            if (og + 1u == (tg + 1u) * nx) xb_add(&bar[XB_TOPGEN], 1u);
            else XB_SPIN(xb_ld(&bar[XB_TOPGEN]) == tg, bar);
            __builtin_amdgcn_fence(__ATOMIC_ACQUIRE, "agent");
            xb_add(&bar[XB_XGEN(b.x)], 1u);
            asm volatile("s_waitcnt vmcnt(0)" ::: "memory");
        } else {
            XB_SPIN(xb_ld(&bar[XB_XGEN(b.x)]) == gen, bar);
            __builtin_amdgcn_fence(__ATOMIC_ACQUIRE, "agent");
            asm volatile("s_waitcnt vmcnt(0)" ::: "memory");
        }
    }
    __syncthreads();
}

struct Args { const float* in[29]; float* out; unsigned char* ws; int ph_lo, ph_hi; };
enum { I_X = 0, I_LNG, I_LNB, I_WIN, I_CONVW, I_QNG, I_WUQ, I_KVNG, I_WUKV, I_LCW, I_LCB, I_LWA, I_LBA, I_LWI, I_LBI, I_LAM, I_MIXG, I_WOUT, I_LN1G, I_LN1B,
       I_DWG, I_DWU, I_DWD, I_RTR, I_MWG, I_MWU, I_MWD, I_LN2G, I_LN2B };
struct Ctx { LAS unsigned char* lds; int tid, lane, wave, G, blk, gw, ngw; };
typedef const __attribute__((address_space(4))) Args* ArgsP;
__device__ __forceinline__ unsigned char* wsp(ArgsP a) { unsigned long long v = (unsigned long long)a->ws; asm volatile("" : "+s"(v)); return (unsigned char*)v; }
__device__ __forceinline__ ArgsP args_ptr() { unsigned long long v = (unsigned long long)__builtin_amdgcn_kernarg_segment_ptr(); asm volatile("" : "+s"(v)); return (ArgsP)v; }

struct RmId { __device__ __forceinline__ int operator()(int n) const { return n; } };
struct RmGU { int up; __device__ __forceinline__ int operator()(int n) const { return 256 * (n >> 7) + 128 * up + (n & 127); } };
struct RmKV { int v; __device__ __forceinline__ int operator()(int n) const { return (n >> 7) * 64 + (n & 63); } };
template <class RM>
__device__ __forceinline__ void transpose_item(const float* W, int N, bf16_t* WT, int ldo, const float* kscale, LAS float* scr, int kb, int nb, int lane, RM rm, float kmul = 1.0f) {
    const int k0 = 64 * kb, n0 = 32 * nb; const int r = lane >> 3, q = lane & 7;
    f32x4 v[8];
#pragma unroll
    for (int i = 0; i < 8; ++i) v[i] = *(const f32x4*)(W + (size_t)(k0 + 8 * i + r) * N + n0 + 4 * q);
#pragma unroll
    for (int i = 0; i < 8; ++i) { LAS float* d = scr + (8 * i + r) * 33 + 4 * q; d[0] = v[i][0]; d[1] = v[i][1]; d[2] = v[i][2]; d[3] = v[i][3]; }
    LDS_WAIT(); asm volatile("" ::: "memory");
    const int c = lane & 7;
    float ks[8];
#pragma unroll
    for (int e = 0; e < 8; ++e) ks[e] = (kscale ? kscale[k0 + 8 * c + e] : 1.0f) * kmul;
#pragma unroll
    for (int j = 0; j < 4; ++j) { const int n = (lane >> 3) + 8 * j; const LAS float* s = scr + (8 * c) * 33 + n;
        u32x4 o; o.x = pk2(s[0 * 33] * ks[0], s[1 * 33] * ks[1]); o.y = pk2(s[2 * 33] * ks[2], s[3 * 33] * ks[3]); o.z = pk2(s[4 * 33] * ks[4], s[5 * 33] * ks[5]); o.w = pk2(s[6 * 33] * ks[6], s[7 * 33] * ks[7]);
        *(u32x4*)(WT + (size_t)rm(n0 + n) * ldo + k0 + 8 * c) = o; }
    LDS_WAIT(); asm volatile("" ::: "memory");
}
template <class RM>
__device__ __forceinline__ void transpose_matrix(const Ctx& C, int& it0, const float* W, int K, int N, bf16_t* WT, int ldo, const float* kscale, RM rm, float kmul = 1.0f) {
    LAS float* scr = (LAS float*)(C.lds + C.wave * 16384);
    const int nkb = K / 64, nnb = N / 32, total = nkb * nnb;
    int first = (C.gw - (it0 % C.ngw) + C.ngw) % C.ngw;
    for (int it = first; it < total; it += C.ngw) transpose_item(W, N, WT, ldo, kscale, scr, it / nnb, it % nnb, C.lane, rm, kmul);
    it0 += total;
}
__device__ __forceinline__ void ln_row(const float* src, const float* g, const float* bta, float* dstf, bf16_t* dstb, int lane, f32x4 (&v)[4]) {
    float s = 0.f;
#pragma unroll
    for (int j = 0; j < 4; ++j) { v[j] = *(const f32x4*)(src + 4 * lane + 256 * j); s += (v[j][0] + v[j][1]) + (v[j][2] + v[j][3]); }
    const float mean = wave_sum(s) * (1.0f / DM); float s2 = 0.f;
#pragma unroll
    for (int j = 0; j < 4; ++j) { v[j] = v[j] - mean; s2 += (v[j][0] * v[j][0] + v[j][1] * v[j][1]) + (v[j][2] * v[j][2] + v[j][3] * v[j][3]); }
    const float rstd = rsqrtf(wave_sum(s2) * (1.0f / DM) + LN_EPS);
#pragma unroll
    for (int j = 0; j < 4; ++j) { const f32x4 gg = *(const f32x4*)(g + 4 * lane + 256 * j), bb = *(const f32x4*)(bta + 4 * lane + 256 * j);
        v[j] = v[j] * rstd * gg + bb; *(f32x4*)(dstf + 4 * lane + 256 * j) = v[j];
        u32x2 w; w.x = pk2(v[j][0], v[j][1]); w.y = pk2(v[j][2], v[j][3]); *(u32x2*)(dstb + 4 * lane + 256 * j) = w; }
}

__device__ __forceinline__ void phase_prologue(const Ctx& C, ArgsP a) {
    unsigned char* ws = wsp(a); int it0 = 0;
    for (int l = 0; l < 2; ++l) {
        transpose_matrix(C, it0, a->in[I_WIN] + (size_t)l * DM * DIN, DM, DIN, (bf16_t*)(ws + WS_WIN) + (size_t)l * DINP * DM, DM, nullptr, RmId{});
        transpose_matrix(C, it0, a->in[I_WUQ] + (size_t)l * QRANK * QW, QRANK, QW, (bf16_t*)(ws + WS_WUQ) + (size_t)l * QW * QRANK, QRANK, a->in[I_QNG] + l * QRANK, RmId{}, QSCALE);
        transpose_matrix(C, it0, a->in[I_WOUT] + (size_t)l * DM * DM, DM, DM, (bf16_t*)(ws + WS_WOUT) + (size_t)l * DM * DM, DM, nullptr, RmId{});
        { LAS float* scr = (LAS float*)(C.lds + C.wave * 16384); const float* W = a->in[I_WUKV] + (size_t)l * KVRANK * 1024; const int total = 4 * 32;
          int first = (C.gw - (it0 % C.ngw) + C.ngw) % C.ngw;
          for (int it = first; it < total; it += C.ngw) { const int kb = it / 32, nb = it % 32; const bool isv = (nb & 3) >= 2;
              transpose_item(W, 1024, (bf16_t*)(ws + (isv ? WS_WV : WS_WK)) + (size_t)l * 512 * KVRANK, KVRANK, a->in[I_KVNG] + l * KVRANK, scr, kb, nb, C.lane, RmKV{0}); }
          it0 += total; }
        for (int d = 0; d < 2; ++d) for (int g = 0; g < 2; ++g) for (int n = 0; n < 4; ++n)
            transpose_matrix(C, it0, a->in[g == 0 ? I_LWA : I_LWI] + (size_t)(((l * 2 + d) * 4 + n) * 4096), 64, 64, (bf16_t*)(ws + WS_LRUW) + (size_t)((((l * 2 + d) * 2 + g) * 4 + n) * 4096), 64, nullptr, RmId{});
    }
    transpose_matrix(C, it0, a->in[I_DWG], DM, DFF, (bf16_t*)(ws + WS_WGU), DM, nullptr, RmGU{0});
    transpose_matrix(C, it0, a->in[I_DWU], DM, DFF, (bf16_t*)(ws + WS_WGU), DM, nullptr, RmGU{1});
    transpose_matrix(C, it0, a->in[I_DWD], DFF, DM, (bf16_t*)(ws + WS_WD), DFF, nullptr, RmId{});
    const int gt = C.blk * 512 + C.tid, ngt = C.G * 512;
    for (int i = gt; i < 2 * 96 * DM / 8; i += ngt) { const int l = i / (96 * DM / 8), r = i % (96 * DM / 8); *(u32x4*)((bf16_t*)(ws + WS_WIN) + (size_t)l * DINP * DM + (size_t)DIN * DM + (size_t)r * 8) = (u32x4){0u, 0u, 0u, 0u}; }
    for (int i = gt; i < 1024; i += ngt) { const float lam = a->in[I_LAM][i]; ((float*)(ws + WS_C8SP))[i] = 8.0f * (fmaxf(-lam, 0.f) + log1pf(expf(-fabsf(lam)))); }
    for (int i = gt; i < SEQ * 16; i += ngt) { const int pos = i >> 4, k = i & 15; const double inv = exp(-9.210340371976184 * (double)k / 16.0); const double ang = (double)pos * inv;
        ((f32x2*)(ws + WS_ROPE))[i] = (f32x2){(float)cos(ang), (float)sin(ang)}; }
    for (int row = C.gw; row < NTOK; row += C.ngw) { f32x4 v[4]; ln_row(a->in[I_X] + (size_t)row * DM, a->in[I_LNG], a->in[I_LNB], a->out + (size_t)row * DM, (bf16_t*)(ws + WS_XB) + (size_t)row * DM, C.lane, v); }
}

__device__ __forceinline__ void phase_tokenlocal(const Ctx& C, ArgsP a, int l) {
    unsigned char* ws = wsp(a); const bf16_t* Z = (const bf16_t*)(ws + WS_Z); bf16_t* Y = (bf16_t*)(ws + WS_Y); bf16_t* KR = (bf16_t*)(ws + WS_KR);
    bf16_t* CQN = (bf16_t*)(ws + WS_CQN); bf16_t* CKVN = (bf16_t*)(ws + WS_CKVN); const f32x2* rope = (const f32x2*)(ws + WS_ROPE);
    const int lane = C.lane;
    const float* cwp = a->in[I_CONVW] + (size_t)l * 3 * 256; const f32x4 w0 = *(const f32x4*)(cwp + 4 * lane), w1 = *(const f32x4*)(cwp + 256 + 4 * lane), w2 = *(const f32x4*)(cwp + 512 + 4 * lane);
    const f32x4 gc = *(const f32x4*)(a->in[I_MIXG] + (size_t)l * DM + 4 * lane);
    for (int row = C.gw; row < NTOK; row += C.ngw) {
        const bf16_t* zr = Z + (size_t)row * DINP; const int pos = row & (SEQ - 1);
        float sq = 0.f; float qx[6];
#pragma unroll
        for (int j = 0; j < 3; ++j) { const unsigned w = *(const unsigned*)(zr + ZC_Q + 2 * lane + 128 * j); qx[2 * j] = bflo(w); qx[2 * j + 1] = bfhi(w); sq += qx[2 * j] * qx[2 * j] + qx[2 * j + 1] * qx[2 * j + 1]; }
        const u32x2 wk = *(const u32x2*)(zr + ZC_KV + 4 * lane); const float k0 = bflo(wk.x), k1 = bfhi(wk.x), k2 = bflo(wk.y), k3 = bfhi(wk.y);
        const float skv = wave_sum(k0 * k0 + k1 * k1 + k2 * k2 + k3 * k3); sq = wave_sum(sq);
        { const float rq = rsqrtf(sq * (1.0f / QRANK) + RMS_EPS), rk = rsqrtf(skv * (1.0f / KVRANK) + RMS_EPS);
#pragma unroll
          for (int j = 0; j < 3; ++j) *(unsigned*)(CQN + (size_t)row * QRANK + 2 * lane + 128 * j) = pk2(qx[2 * j] * rq, qx[2 * j + 1] * rq);
          u32x2 o; o.x = pk2(k0 * rk, k1 * rk); o.y = pk2(k2 * rk, k3 * rk); *(u32x2*)(CKVN + (size_t)row * KVRANK + 4 * lane) = o; }
        if (lane < 16) { const float x1 = bf2f(zr[ZC_KR + lane]), x2 = bf2f(zr[ZC_KR + 16 + lane]); const f32x2 cs = rope[(size_t)pos * 16 + lane];
            KR[(size_t)row * 32 + lane] = (bf16_t)f2bf(x1 * cs[0] - x2 * cs[1]); KR[(size_t)row * 32 + 16 + lane] = (bf16_t)f2bf(x2 * cs[0] + x1 * cs[1]); }
        f32x4 acc = (f32x4){0.f, 0.f, 0.f, 0.f};
#pragma unroll
        for (int k = 0; k < 3; ++k) { const int p2 = pos + k - 1;
            if (p2 >= 0 && p2 < SEQ) { const bf16_t* zz = zr + (ptrdiff_t)(k - 1) * DINP; const u32x2 cw_ = *(const u32x2*)(zz + ZC_C + 4 * lane), hw = *(const u32x2*)(zz + ZC_H + 4 * lane);
                const f32x4 ch = (f32x4){bflo(cw_.x) * bflo(hw.x), bfhi(cw_.x) * bfhi(hw.x), bflo(cw_.y) * bflo(hw.y), bfhi(cw_.y) * bfhi(hw.y)};
                acc += (k == 0 ? w0 : (k == 1 ? w1 : w2)) * ch; } }
        const u32x2 bw = *(const u32x2*)(zr + ZC_B + 4 * lane);
        acc = acc * (f32x4){bflo(bw.x), bfhi(bw.x), bflo(bw.y), bfhi(bw.y)};
        const float ss = wave_sum(acc[0] * acc[0] + acc[1] * acc[1] + acc[2] * acc[2] + acc[3] * acc[3]); const float rs = rsqrtf(ss * (1.0f / 256.0f) + RMS_EPS);
        u32x2 o; o.x = pk2(acc[0] * rs * gc[0], acc[1] * rs * gc[1]); o.y = pk2(acc[2] * rs * gc[2], acc[3] * rs * gc[3]);
        *(u32x2*)(Y + (size_t)row * DM + 4 * lane) = o;
    }
    for (int u = C.blk; u < NBATCH * LRU_NCH; u += C.G)
        lru::lru_unit<1>(u / LRU_NCH, u % LRU_NCH, l, Z, (const bf16_t*)(ws + WS_LRUW), (const float*)(ws + WS_C8SP), a->in[I_LCW], a->in[I_LCB], a->in[I_LBA], a->in[I_LBI],
                         (float*)(ws + WS_AGGA), (float*)(ws + WS_AGGH), a->in[I_MIXG] + (size_t)l * DM + 768, Y, C.lds);
}

__device__ __forceinline__ void phase_mlanorm(const Ctx& C, ArgsP a, int l) {
    bf16_t* Y = (bf16_t*)(a->ws + WS_Y); const int lane = C.lane; const float* g = a->in[I_MIXG] + (size_t)l * DM + 256 + 8 * lane;
    const f32x4 g0 = *(const f32x4*)g, g1 = *(const f32x4*)(g + 4);
    for (int row = C.gw; row < NTOK; row += C.ngw) { u32x4* p = (u32x4*)(Y + (size_t)row * DM + 256 + 8 * lane); const u32x4 w = *p;
        float v[8] = {bflo(w.x), bfhi(w.x), bflo(w.y), bfhi(w.y), bflo(w.z), bfhi(w.z), bflo(w.w), bfhi(w.w)}; float s = 0.f;
#pragma unroll
        for (int e = 0; e < 8; ++e) s += v[e] * v[e];
        const float rs = rsqrtf(wave_sum(s) * (1.0f / 512.0f) + RMS_EPS);
        u32x4 o; o.x = pk2(v[0] * rs * g0[0], v[1] * rs * g0[1]); o.y = pk2(v[2] * rs * g0[2], v[3] * rs * g0[3]); o.z = pk2(v[4] * rs * g1[0], v[5] * rs * g1[1]); o.w = pk2(v[6] * rs * g1[2], v[7] * rs * g1[3]);
        *p = o; }
}

template <bool ROUTE>
__device__ __forceinline__ void phase_ln(const Ctx& C, ArgsP a, const float* g, const float* bta) {
    unsigned char* ws = wsp(a); float* X = a->out; bf16_t* XB = (bf16_t*)(ws + WS_XB);
    LAS float* wr_ = (LAS float*)C.lds;
    LAS unsigned* hist = (LAS unsigned*)(C.lds + 32768);
    unsigned* cnt = (unsigned*)(ws + WS_CTL) + CW_CNT;
    int* tok_e = (int*)(ws + WS_TOKE); int* tok_r = (int*)(ws + WS_TOKR); float* tok_g = (float*)(ws + WS_TOKG);
    if (ROUTE) {
        for (int i = C.tid; i < DM * NEXP / 4; i += 512) ((LAS f32x4*)wr_)[i] = ((const f32x4*)a->in[I_RTR])[i];
        if (C.tid < 32) hist[C.tid] = 0u;
        __syncthreads();
    }
    for (int row = C.gw; row < NTOK; row += C.ngw) {
        f32x4 v[4]; ln_row(X + (size_t)row * DM, g, bta, X + (size_t)row * DM, XB + (size_t)row * DM, C.lane, v);
        if (ROUTE) {
            float lg[8];
#pragma unroll
            for (int e = 0; e < 8; ++e) lg[e] = 0.f;
#pragma unroll
            for (int j = 0; j < 4; ++j)
#pragma unroll
                for (int q = 0; q < 4; ++q) { const int c = 4 * C.lane + 256 * j + q; const f32x4 wa = *(const LAS f32x4*)(wr_ + c * 8), wb = *(const LAS f32x4*)(wr_ + c * 8 + 4); const float x = v[j][q];
                    lg[0] += x * wa[0]; lg[1] += x * wa[1]; lg[2] += x * wa[2]; lg[3] += x * wa[3]; lg[4] += x * wb[0]; lg[5] += x * wb[1]; lg[6] += x * wb[2]; lg[7] += x * wb[3]; }
#pragma unroll
            for (int e = 0; e < 8; ++e) lg[e] = wave_sum(lg[e]);
            int e0 = 0; float v0 = lg[0];
#pragma unroll
            for (int e = 1; e < 8; ++e) if (lg[e] > v0) { v0 = lg[e]; e0 = e; }
            int e1 = -1; float v1 = -INFINITY;
#pragma unroll
            for (int e = 0; e < 8; ++e) if (e != e0 && lg[e] > v1) { v1 = lg[e]; e1 = e; }
            const float g0 = 1.0f / (1.0f + expf(v1 - v0)), g1 = 1.0f - g0;
            if (C.lane == 0) { const unsigned r0 = atomicAdd((unsigned*)&hist[e0], 1u), r1 = atomicAdd((unsigned*)&hist[8 + e1], 1u);
                tok_e[row] = e0; tok_e[NTOK + row] = e1; tok_r[row] = (int)r0; tok_r[NTOK + row] = (int)r1; tok_g[row] = g0; tok_g[NTOK + row] = g1; }
        }
    }
    if (ROUTE) {
        VM_WAIT(); __syncthreads();
        if (C.tid < 16) hist[16 + C.tid] = atomicAdd(&cnt[C.tid], hist[C.tid]);
        __syncthreads();
        int* list = (int*)(ws + WS_LIST); float* glist = (float*)(ws + WS_GLIST);
        for (int row = C.gw; row < NTOK; row += C.ngw) {
            if (C.lane < 2) { const int p = C.lane; const int e = tok_e[p * NTOK + row]; const int slot = (int)hist[16 + p * 8 + e] + tok_r[p * NTOK + row];
                list[(size_t)(p * 8 + e) * NTOK + slot] = row; glist[(size_t)(p * 8 + e) * NTOK + slot] = tok_g[p * NTOK + row]; } }
        __syncthreads();
        int it0 = 0;
        for (int e = 0; e < NEXP; ++e) {
            transpose_matrix(C, it0, a->in[I_MWG] + (size_t)e * DM * DFF, DM, DFF, (bf16_t*)(ws + WS_WGUM) + (size_t)e * 2 * DFF * DM, DM, nullptr, RmGU{0});
            transpose_matrix(C, it0, a->in[I_MWU] + (size_t)e * DM * DFF, DM, DFF, (bf16_t*)(ws + WS_WGUM) + (size_t)e * 2 * DFF * DM, DM, nullptr, RmGU{1});
            transpose_matrix(C, it0, a->in[I_MWD] + (size_t)e * DFF * DM, DFF, DM, (bf16_t*)(ws + WS_WDM) + (size_t)e * DM * DFF, DFF, nullptr, RmId{});
        }
    }
}

constexpr int NPH_LAYER = 12, NPHASES = 1 + 2 * NPH_LAYER;
template <int KSEL>
__global__ void __launch_bounds__(512, 2) fwd_kernel(Args a_) {
    extern __shared__ __attribute__((aligned(16))) unsigned char lds_raw[];
    Ctx C0; C0.lds = (LAS unsigned char*)lds_raw; C0.tid = threadIdx.x; C0.lane = C0.tid & 63; C0.wave = __builtin_amdgcn_readfirstlane(C0.tid >> 6);
    C0.G = gridDim.x; C0.blk = blockIdx.x; C0.gw = C0.blk * 8 + C0.wave; C0.ngw = C0.G * 8;
    unsigned char* ws0 = a_.ws;
    volatile LAS unsigned* MISC = (volatile LAS unsigned*)(C0.lds + MISC_OFF);
    if (C0.tid < 64) MISC[C0.tid] = 0u;
    __syncthreads();
    XcdBarrier bar; bar.bar = (unsigned*)(ws0 + WS_CTL) + CW_BAR; bar.x = 0; bar.st = MISC + 8;
    const int lo = a_.ph_lo, hi = a_.ph_hi;
    const bool multi = (KSEL < 0) && (hi - lo) > 1;
    if (multi) bar = xcd_barrier_post((unsigned*)(ws0 + WS_CTL) + CW_BAR, MISC + 8);
#define IN(k) (KSEL < 0 ? (lo <= (k) && (k) < hi) : (KSEL == 100 ? (k) == 0 : ((k) > 0 && KSEL == ((k) - 1) % NPH_LAYER && (k) == lo)))
#define SITE Ctx C = C0; { int t_ = threadIdx.x; asm volatile("" : "+v"(t_)); C.tid = t_; C.lane = t_ & 63; } ArgsP a = args_ptr(); unsigned char* ws = wsp(a); const bf16_t* XB = (const bf16_t*)(ws + WS_XB); bf16_t* Z = (bf16_t*)(ws + WS_Z); bf16_t* Y = (bf16_t*)(ws + WS_Y); (void)XB; (void)Z; (void)Y; (void)a
#define MOEP const unsigned* cnt = (const unsigned*)(ws + WS_CTL) + CW_CNT; const int* list = (const int*)(ws + WS_LIST); const float* glist = (const float*)(ws + WS_GLIST); (void)glist
#define REP(j) for (int rep_ = 0; rep_ < (((PROBE_REPEAT >> (j)) & 1) ? 2 : 1); ++rep_)
#define INJ(j) (KSEL < 0 ? (lo <= pb + (j) && pb + (j) < hi) : (KSEL == (j) && lo == pb + (j)))
#define SEAM(k) do { if (KSEL < 0) { if (multi && (k) + 1 < hi) xcd_barrier(bar); } } while (0)
    if (IN(0)) { Ctx C = C0; { int t_ = threadIdx.x; asm volatile("" : "+v"(t_)); C.tid = t_; C.lane = t_ & 63; } ArgsP a = args_ptr(); phase_prologue(C, a); SEAM(0); }
#pragma unroll 1
    for (int l = 0; l < 2; ++l) {
        const int pb = 1 + NPH_LAYER * l;
        if (INJ(0)) REP(0) { SITE;
            pg8::Gemm g{XB, (const bf16_t*)(ws + WS_WIN) + (size_t)l * DINP * DM, DM, DM, DM}; pg8::StaticOrder S; S.init(NTOK, DINP, C.G, C.blk, DM, DM);
            EpiStore E{Z, DINP, nullptr};
            pg8::gemm_phase<EpiStore, pg8::StaticOrder, true, false>(C.lds, g, S, E);
            SEAM(pb + 0);
        }
        if (INJ(1)) REP(1) { SITE; phase_tokenlocal(C, a, l); SEAM(pb + 1); }
        if (INJ(2)) REP(2) { SITE;
#if !defined(UPSEL) || UPSEL == 1
            { pg8::Gemm g{(const bf16_t*)(ws + WS_CQN), (const bf16_t*)(ws + WS_WUQ) + (size_t)l * QW * QRANK, QRANK, QRANK, QRANK}; pg8::StaticOrder S; S.init(NTOK, QW, C.G, C.blk, QRANK, QRANK);
              EpiQ E{(bf16_t*)(ws + WS_Q), (const f32x2*)(ws + WS_ROPE)};
              pg8::gemm_phase<EpiQ, pg8::StaticOrder, true, false>(C.lds, g, S, E); }
#endif
#if !defined(UPSEL) || UPSEL == 2
            { pg8::Gemm g{(const bf16_t*)(ws + WS_CKVN), (const bf16_t*)(ws + WS_WK) + (size_t)l * 512 * KVRANK, KVRANK, KVRANK, KVRANK}; pg8::StaticOrder S; S.init(NTOK, 512, C.G, C.blk, KVRANK, KVRANK);
              EpiStore E{(bf16_t*)(ws + WS_KN), 512, nullptr};
              pg8::gemm_phase<EpiStore, pg8::StaticOrder, true, false>(C.lds, g, S, E); }
#endif
#if !defined(UPSEL) || UPSEL == 3
            { pg8::Gemm g{(const bf16_t*)(ws + WS_WV) + (size_t)l * 512 * KVRANK, (const bf16_t*)(ws + WS_CKVN), KVRANK, KVRANK, KVRANK}; pg8::StaticOrder S; S.init(512, NTOK, C.G, C.blk, KVRANK, KVRANK);
              EpiVT E{(bf16_t*)(ws + WS_VT)};
              pg8::gemm_phase<EpiVT, pg8::StaticOrder, true, false>(C.lds, g, S, E); }
#endif
            SEAM(pb + 2);
        }
        if (INJ(3)) REP(3) { SITE;
            for (int u = C.blk; u < NBATCH * LRU_NCH; u += C.G)
                lru::lru_unit<2>(u / LRU_NCH, u % LRU_NCH, l, Z, (const bf16_t*)(ws + WS_LRUW), (const float*)(ws + WS_C8SP), a->in[I_LCW], a->in[I_LCB], a->in[I_LBA], a->in[I_LBI],
                                 (float*)(ws + WS_AGGA), (float*)(ws + WS_AGGH), a->in[I_MIXG] + (size_t)l * DM + 768, Y, C.lds);
            const int nun = NBATCH * 8 * (SEQ / 256);
            for (int i = 0; ; ++i) {
                int bh, qb;
                if (C.G == 256) { if (i >= 4) break; bh = i * 8 + (C.blk & 7); qb = C.blk >> 3; }
                else { const int L = i * C.G + C.blk; if (L >= nun) break; bh = L >> 5; qb = L & 31; }
                att::attn_unit(bh >> 3, bh & 7, qb, (const bf16_t*)(ws + WS_Q), (const bf16_t*)(ws + WS_KN), (const bf16_t*)(ws + WS_KR), (const bf16_t*)(ws + WS_VT), Y, C.lds);
            }
            SEAM(pb + 3);
        }
        if (INJ(4)) { SITE; phase_mlanorm(C, a, l); SEAM(pb + 4); }
        if (INJ(5)) { SITE;
            pg8::Gemm g{Y, (const bf16_t*)(ws + WS_WOUT) + (size_t)l * DM * DM, DM, DM, DM}; pg8::StaticOrder S; S.init(NTOK, DM, C.G, C.blk, DM, DM);
            EpiResid E{a->out};
            pg8::gemm_phase<EpiResid, pg8::StaticOrder, true, false>(C.lds, g, S, E);
            SEAM(pb + 5);
        }
        if (INJ(6)) { SITE;
            if (l == 0) phase_ln<false>(C, a, a->in[I_LN1G] + (size_t)l * DM, a->in[I_LN1B] + (size_t)l * DM);
            else phase_ln<true>(C, a, a->in[I_LN1G] + (size_t)l * DM, a->in[I_LN1B] + (size_t)l * DM);
            SEAM(pb + 6);
        }
        if (l == 0) {
            if (INJ(7)) REP(7) { SITE;
                pg8::Gemm g{XB, (const bf16_t*)(ws + WS_WGU), DM, DM, DM}; pg8::StaticOrder S; S.init(NTOK, 2 * DFF, C.G, C.blk, DM, DM);
                EpiSwiglu E{(bf16_t*)(ws + WS_H)};
                pg8::gemm_phase<EpiSwiglu, pg8::StaticOrder, true, false>(C.lds, g, S, E);
                SEAM(pb + 7);
            }
            if (INJ(8)) { SITE;
                pg8::Gemm g{(const bf16_t*)(ws + WS_H), (const bf16_t*)(ws + WS_WD), DFF, DFF, DFF}; pg8::StaticOrder S; S.init(NTOK, DM, C.G, C.blk, DFF, DFF);
                EpiResid E{a->out};
                pg8::gemm_phase<EpiResid, pg8::StaticOrder, true, false>(C.lds, g, S, E);
                SEAM(pb + 8);
            }
        } else {
#pragma unroll
            for (int p = 0; p < 2; ++p) {
                if (INJ(7 + 2 * p)) REP(7) { SITE; MOEP;
                    pg8::Gemm g{XB, (const bf16_t*)(ws + WS_WGUM), DM, DM, DM}; pg8::MoeOrder S; S.init(cnt, p, 2 * DFF / 256, C.G, C.blk, list, 0, DM, DM, (size_t)2 * DFF * DM * 2);
                    EpiSwiglu E{(bf16_t*)(ws + WS_HM)};
                    pg8::gemm_phase<EpiSwiglu, pg8::MoeOrder, true, true>(C.lds, g, S, E);
                    SEAM(pb + 7 + 2 * p);
                }
                if (INJ(8 + 2 * p)) { SITE; MOEP;
                    pg8::Gemm g{(const bf16_t*)(ws + WS_HM), (const bf16_t*)(ws + WS_WDM), DFF, DFF, DFF}; pg8::MoeOrder S; S.init(cnt, p, DM / 256, C.G, C.blk, list, 1, DFF, DFF, (size_t)DM * DFF * 2);
                    EpiMoeDown E{a->out, list, glist, p};
                    pg8::gemm_phase<EpiMoeDown, pg8::MoeOrder, true, false>(C.lds, g, S, E);
                    SEAM(pb + 8 + 2 * p);
                }
            }
        }
        if (INJ(11)) { SITE; phase_ln<false>(C, a, a->in[I_LN2G] + (size_t)l * DM, a->in[I_LN2B] + (size_t)l * DM); SEAM(pb + 11); }
    }
#undef IN
#undef INJ
#undef SITE
#undef REP
#undef MOEP
#undef SEAM
}

#if MEGA
constexpr int NKERN = 1;
static const void* kern_tab(int) { return (const void*)fwd_kernel<-1>; }
#else
constexpr int NKERN = 13;
static const void* kern_tab(int k) {
    switch (k) { case 0: return (const void*)fwd_kernel<0>; case 1: return (const void*)fwd_kernel<1>; case 2: return (const void*)fwd_kernel<2>; case 3: return (const void*)fwd_kernel<3>;
        case 4: return (const void*)fwd_kernel<4>; case 5: return (const void*)fwd_kernel<5>; case 6: return (const void*)fwd_kernel<6>; case 7: return (const void*)fwd_kernel<7>;
        case 8: return (const void*)fwd_kernel<8>; case 9: return (const void*)fwd_kernel<9>; case 10: return (const void*)fwd_kernel<10>; case 11: return (const void*)fwd_kernel<11>;
        default: return (const void*)fwd_kernel<100>; }
}
#endif
extern "C" void kernel_launch(void* const* d_in, const int* in_sizes, int n_in, void* d_out, int out_size, void* d_ws, size_t ws_size, hipStream_t stream) {
    static int grid = 0;
    if (grid == 0) {
        if (n_in != 29 || in_sizes[0] != NTOK * DM || out_size != NTOK * DM || ws_size < WS_END) { fprintf(stderr, "kernel_launch: unexpected shapes / workspace (%d inputs, ws %zu < %zu)\n", n_in, ws_size, (size_t)WS_END); grid = -1; return; }
        int dev = 0, cus = 0, per_cu = 0;
        if (hipGetDevice(&dev) != hipSuccess || hipDeviceGetAttribute(&cus, hipDeviceAttributeMultiprocessorCount, dev) != hipSuccess) { grid = -1; return; }
        for (int k = 0; k < NKERN; ++k) if (hipFuncSetAttribute(kern_tab(k), hipFuncAttributeMaxDynamicSharedMemorySize, LDS_BYTES) != hipSuccess) { fprintf(stderr, "kernel_launch: hipFuncSetAttribute failed\n"); grid = -1; return; }
        if (hipOccupancyMaxActiveBlocksPerMultiprocessor(&per_cu, kern_tab(0), 512, LDS_BYTES) != hipSuccess || per_cu < 1) { fprintf(stderr, "kernel_launch: occupancy query says %d\n", per_cu); }
        (void)hipGetLastError();
        grid = cus;
    }
    if (grid < 0) return;
    (void)hipMemsetAsync((char*)d_ws + WS_CTL, 0, CTL_ZERO_BYTES, stream);
    Args a{};
    for (int i = 0; i < 29; ++i) a.in[i] = (const float*)d_in[i];
    a.out = (float*)d_out; a.ws = (unsigned char*)d_ws;
#if MEGA
    a.ph_lo = 0; a.ph_hi = NPHASES;
    hipLaunchKernelGGL(fwd_kernel<-1>, dim3(grid), dim3(512), LDS_BYTES, stream, a);
#else
    for (int ph = 0; ph < NPHASES; ++ph) {
        if (ph == 1 + 9 || ph == 1 + 10) continue;
        a.ph_lo = ph; a.ph_hi = ph + 1;
        void* args[] = {&a};
        (void)hipLaunchKernel(kern_tab(ph == 0 ? 12 : (ph - 1) % NPH_LAYER), dim3(grid), dim3(512), args, LDS_BYTES, stream);
    }
#endif
}
```
